# Optimizing an MI355X kernel written in HIP

```python
import math
import jax, jax.numpy as jnp
from jax import lax
import numpy as np

D_MODEL = 1024
BATCH = 2
SEQ = 8192
DEPTH = 1

N_META = 16
MIX_WIDTH = D_MODEL
POOL_WIDTH = MIX_WIDTH // 2
POOL_WINDOWS = (2, 4, 8, 16)
POOL_GROUPS = len(POOL_WINDOWS)
POOL_GROUP_DIM = POOL_WIDTH // POOL_GROUPS
ATTN_WIDTH = MIX_WIDTH - POOL_WIDTH
N_HEADS = 4
V_DIM = ATTN_WIDTH // N_HEADS
QK_DIM = V_DIM // 2
QK_COLS = N_HEADS * 2 * QK_DIM
IN_COLS = POOL_WIDTH + 2 * QK_COLS + ATTN_WIDTH
D_FF = 2816
CONV_WIDTH = 3
Q_BLOCK = 128
EPS = 1e-6

kernel_name = "hymba_pool_diffattn_convglu"


def rmsnorm(x, g):
    xf = x.astype(jnp.float32)
    y = xf * lax.rsqrt(jnp.mean(xf * xf, axis=-1, keepdims=True) + EPS)
    return (y * g.astype(jnp.float32)).astype(x.dtype)


def causal_multiscale_pool(u):
    B, L, _ = u.shape
    ug = u.reshape(B, L, POOL_GROUPS, POOL_GROUP_DIM).astype(jnp.float32)
    cs = jnp.cumsum(ug, axis=1)
    t = jnp.arange(L)
    outs = []
    for g, w in enumerate(POOL_WINDOWS):
        c = cs[:, :, g]
        prev = jnp.pad(c, ((0, 0), (w, 0), (0, 0)))[:, :L]
        cnt = jnp.minimum(t + 1, w).astype(jnp.float32)[None, :, None]
        outs.append((c - prev) / cnt - ug[:, :, g])
    return jnp.stack(outs, axis=2)


def diff_attention(q, k, v, lam, lam_init, subln_g):
    B, L = q.shape[:2]
    Lp = -(-L // Q_BLOCK) * Q_BLOCK
    pad = Lp - L
    q = jnp.pad(q, ((0, 0), (0, pad), (0, 0), (0, 0), (0, 0)))
    k = jnp.pad(k, ((0, 0), (0, pad), (0, 0), (0, 0), (0, 0)))
    v = jnp.pad(v, ((0, 0), (0, pad), (0, 0), (0, 0)))
    kt = k.transpose(0, 2, 3, 1, 4)
    vt = v.transpose(0, 2, 1, 3)
    nblk = Lp // Q_BLOCK
    qb = q.reshape(B, nblk, Q_BLOCK, N_HEADS, 2, QK_DIM).transpose(1, 0, 3, 4, 2, 5)
    key_pos = jnp.arange(Lp)
    scale = QK_DIM ** -0.5

    def one_block(args):
        qblk, i = args
        s = jnp.einsum('bhcqd,bhckd->bhcqk', qblk, kt).astype(jnp.float32) * scale
        q_pos = i * Q_BLOCK + jnp.arange(Q_BLOCK)
        mask = key_pos[None, :] <= q_pos[:, None]
        s = jnp.where(mask, s, -jnp.inf)
        p = jax.nn.softmax(s, axis=-1)
        a = p[:, :, 0] - lam * p[:, :, 1]
        return jnp.einsum('bhqk,bhkd->bqhd', a.astype(vt.dtype), vt)

    o = lax.map(one_block, (qb, jnp.arange(nblk)))
    o = o.transpose(1, 0, 2, 3, 4).reshape(B, Lp, N_HEADS, V_DIM)[:, :L]
    o = rmsnorm(o, subln_g) * (1.0 - lam_init)
    return o.reshape(B, L, ATTN_WIDTH)


def conv_glu_ffn(h, w_up, conv_w, conv_b, w_down):
    u = h @ w_up
    L = u.shape[1]
    up = jnp.pad(u, ((0, 0), (CONV_WIDTH - 1, 0), (0, 0)))
    c = up[:, 0:L] * conv_w[0] + up[:, 1:L + 1] * conv_w[1] + up[:, 2:L + 2] * conv_w[2] + conv_b
    gate, val = jnp.split(c, 2, axis=-1)
    return (jax.nn.silu(gate) * val) @ w_down


def setup_inputs(seed: int = 0) -> dict:
    key = jax.random.key(seed)
    ks = jax.random.split(key, 20)
    f32 = jnp.float32
    nrm = lambda k, shape, s: (jax.random.normal(k, shape, f32) * s)
    Dp = DEPTH
    return {
        "x": nrm(ks[0], (BATCH, SEQ, D_MODEL), 1.0),
        "meta_tokens": nrm(ks[1], (N_META, D_MODEL), 1.0),
        "norm_mix_g": 1.0 + nrm(ks[2], (Dp, D_MODEL), 0.02),
        "w_in": nrm(ks[3], (Dp, D_MODEL, IN_COLS), D_MODEL ** -0.5),
        "w_pool": nrm(ks[4], (Dp, POOL_GROUPS, POOL_GROUP_DIM, POOL_GROUP_DIM), POOL_GROUP_DIM ** -0.5),
        "b_pool": nrm(ks[5], (Dp, POOL_GROUPS, POOL_GROUP_DIM), 0.02),
        "pool_scale": 1.0 + nrm(ks[6], (Dp, POOL_WIDTH), 0.05),
        "q_norm_g": 1.0 + nrm(ks[7], (Dp, QK_DIM), 0.02),
        "k_norm_g": 1.0 + nrm(ks[8], (Dp, QK_DIM), 0.02),
        "lambda_q1": nrm(ks[9], (Dp, QK_DIM), 0.1),
        "lambda_k1": nrm(ks[10], (Dp, QK_DIM), 0.1),
        "lambda_q2": nrm(ks[11], (Dp, QK_DIM), 0.1),
        "lambda_k2": nrm(ks[12], (Dp, QK_DIM), 0.1),
        "subln_g": 1.0 + nrm(ks[13], (Dp, V_DIM), 0.02),
        "w_out": nrm(ks[14], (Dp, MIX_WIDTH, D_MODEL), MIX_WIDTH ** -0.5),
        "norm_ffn_g": 1.0 + nrm(ks[15], (Dp, D_MODEL), 0.02),
        "w_up": nrm(ks[16], (Dp, D_MODEL, 2 * D_FF), D_MODEL ** -0.5),
        "conv_w": nrm(ks[17], (Dp, CONV_WIDTH, 2 * D_FF), 0.3) + jnp.array([0.0, 0.0, 1.0], f32)[None, :, None],
        "conv_b": nrm(ks[18], (Dp, 2 * D_FF), 0.02),
        "w_down": nrm(ks[19], (Dp, D_FF, D_MODEL), D_FF ** -0.5),
    }


def reference(x, meta_tokens, norm_mix_g, w_in, w_pool, b_pool, pool_scale, q_norm_g, k_norm_g,
              lambda_q1, lambda_k1, lambda_q2, lambda_k2, subln_g, w_out, norm_ffn_g,
              w_up, conv_w, conv_b, w_down):
    B = x.shape[0]
    meta = jnp.broadcast_to(meta_tokens[None].astype(x.dtype), (B, N_META, D_MODEL))
    h = jnp.concatenate([meta, x], axis=1)
    L = h.shape[1]
    for i in range(DEPTH):
        lam_init = 0.8 - 0.6 * math.exp(-0.3 * i)
        n = rmsnorm(h, norm_mix_g[i])
        proj = n @ w_in[i]
        u, q, k, v = jnp.split(proj, [POOL_WIDTH, POOL_WIDTH + QK_COLS, POOL_WIDTH + 2 * QK_COLS], axis=-1)
        pooled = causal_multiscale_pool(u)
        ya = jnp.einsum('blgc,gcd->blgd', pooled, w_pool[i].astype(jnp.float32)) + b_pool[i].astype(jnp.float32)
        ya = (ya.reshape(B, L, POOL_WIDTH) * pool_scale[i].astype(jnp.float32)).astype(h.dtype)
        q = rmsnorm(q.reshape(B, L, N_HEADS, 2, QK_DIM), q_norm_g[i])
        k = rmsnorm(k.reshape(B, L, N_HEADS, 2, QK_DIM), k_norm_g[i])
        v = v.reshape(B, L, N_HEADS, V_DIM)
        lam = (jnp.exp(jnp.sum(lambda_q1[i].astype(jnp.float32) * lambda_k1[i].astype(jnp.float32)))
               - jnp.exp(jnp.sum(lambda_q2[i].astype(jnp.float32) * lambda_k2[i].astype(jnp.float32)))
               + lam_init)
        yb = diff_attention(q, k, v, lam, lam_init, subln_g[i])
        mix = jnp.concatenate([ya, yb], axis=-1)
        h = h + mix @ w_out[i]
        h = h + conv_glu_ffn(rmsnorm(h, norm_ffn_g[i]), w_up[i], conv_w[i], conv_b[i], w_down[i])
    return h[:, N_META:]
```

```cpp
#include <hip/hip_runtime.h>
#include <cstdio>
#include <cstdint>
namespace pg8 {
#define PG8_LAS __attribute__((address_space(3)))
typedef unsigned short bf16_t;
typedef short bf16x8 __attribute__((ext_vector_type(8)));
typedef float f32x4 __attribute__((ext_vector_type(4)));
typedef unsigned u32x4 __attribute__((ext_vector_type(4)));
constexpr int BM = 256, BK = 64, HALF = 128, HTB = HALF * BK * 2  , STAGE_BYTES = 8 * HTB, NXCD = 8, WGM = 8;

__host__ __device__ __forceinline__ int lds_byte(int r, int c) { const int st = (r >> 4) * 2 + (c >> 5), rr = r & 15, cc = c & 31, ob = rr * 64 + cc * 2; return st * 1024 + (ob ^ (((ob >> 9) & 1) << 5)); }
__host__ __device__ __forceinline__ void stage_rc(int b, int& R, int& C) { const int st = b / 1024, sb = b % 1024, swz = sb ^ (((sb >> 9) & 1) << 5); R = (st >> 1) * 16 + swz / 64; C = (st & 1) * 32 + (swz % 64) / 2; }
__host__ __device__ __forceinline__ int perm32(int rho) { const int n = rho >> 4, i = rho & 15; return 8 * (i >> 2) + 4 * n + (i & 3); }

struct Unit { int pm, pn; };
struct Gemm { const bf16_t* A; const bf16_t* Bt; int M, N, K; };

struct StaticOrder {
    int nM, nN, nwg, G, c;
    __host__ __device__ void init(int M, int N, int G_, int c_) { nM = M / BM; nN = N / BM; nwg = nM * nN; G = G_; c = c_; }
    __host__ __device__ bool next(int i, Unit& u) const {
        const long L = (long)i * G + c; if (L >= nwg) return false;
        int wgid = (int)L; { const int q = nwg / NXCD, r = nwg % NXCD, xcd = wgid % NXCD, off = wgid / NXCD; wgid = (xcd < r ? xcd * (q + 1) : r * (q + 1) + (xcd - r) * q) + off; }
        const int nig = WGM * nN, gid = wgid / nig, fm = gid * WGM, gsz = (nM - fm) < WGM ? (nM - fm) : WGM;
        u.pm = fm + ((wgid % nig) % gsz); u.pn = (wgid % nig) / gsz; return true;
    }
    __device__ __forceinline__ void a_ready(const Unit&) const {}
    __device__ __forceinline__ void done(const Unit&) const {}
};

__device__ __forceinline__ unsigned cvt_pk_bf16(float lo, float hi) { unsigned r; asm volatile("v_cvt_pk_bf16_f32 %0, %1, %2" : "=v"(r) : "v"(lo), "v"(hi)); return r; }
typedef float f32x2 __attribute__((ext_vector_type(2)));
typedef float f32x2 __attribute__((ext_vector_type(2)));
typedef unsigned u32x2 __attribute__((ext_vector_type(2)));
__device__ __forceinline__ __amdgpu_buffer_rsrc_t wt_rsrc(void* base, unsigned bytes) { return __builtin_amdgcn_make_buffer_rsrc(base, 0, (int)bytes, 0x00020000); }
__device__ __forceinline__ void store16_wt(__amdgpu_buffer_rsrc_t r, unsigned byte_off, u32x4 v) { __builtin_amdgcn_raw_buffer_store_b128(v, r, byte_off, 0, 16); }

struct EpiQKV {
    static constexpr bool PERM = true, AFTER_DRAIN = false;
    bf16_t* O; size_t split_stride; int kv_pad; const float* gq; const float* gk; float qscale;
    __device__ __forceinline__ void operator()(const f32x4 (&acc)[2][2][4][2], const Unit& u, int wr, int wc, int fr, int fq) const {
        const int t = u.pn >> 1, colt = (u.pn & 1) * BM; const __amdgpu_buffer_rsrc_t outr = wt_rsrc(O, (unsigned)(4 * split_stride * 2)); const unsigned tb = (unsigned)(t * split_stride * 2);
        const int row0 = u.pm * BM + wr * 64 + fr + (t >= 2 ? kv_pad * ((u.pm >> 5) + 1) : 0);
        if (t == 1 || t == 2) {
            const float* gp = (t == 1) ? gq : gk; const float sc = (t == 1) ? qscale : 1.0f; f32x4 gv[2][2];
#pragma unroll
            for (int bj = 0; bj < 2; ++bj)
#pragma unroll
                for (int n = 0; n < 2; ++n) gv[bj][n] = *(const f32x4*)(gp + 32 * bj + 8 * fq + 4 * n) * sc;
            const int col0 = colt + 64 * wc + 8 * fq;
#pragma unroll
            for (int ai = 0; ai < 2; ++ai)
#pragma unroll
                for (int m = 0; m < 4; ++m) { float s = 0.f;
#pragma unroll
                    for (int bj = 0; bj < 2; ++bj)
#pragma unroll
                        for (int n = 0; n < 2; ++n) { const f32x4 v = acc[ai][bj][m][n]; s += (v[0] * v[0] + v[1] * v[1]) + (v[2] * v[2] + v[3] * v[3]); }
                    s += __shfl_xor(s, 16); s += __shfl_xor(s, 32);
                    const float rs = __builtin_amdgcn_rsqf(s * (1.0f / 64.0f) + 1e-6f);
                    const unsigned rowb_ = tb + (unsigned)(((row0 + ai * HALF + m * 16) * 512 + col0) * 2);
#pragma unroll
                    for (int bj = 0; bj < 2; ++bj) { const f32x4 v0 = acc[ai][bj][m][0] * rs * gv[bj][0], v1 = acc[ai][bj][m][1] * rs * gv[bj][1];
                        u32x4 w; w.x = cvt_pk_bf16(v0[0], v0[1]); w.y = cvt_pk_bf16(v0[2], v0[3]); w.z = cvt_pk_bf16(v1[0], v1[1]); w.w = cvt_pk_bf16(v1[2], v1[3]);
                        store16_wt(outr, rowb_ + bj * 64, w); } }
        } else {
            const int col0 = colt + wc * 32 + 8 * fq;
#pragma unroll
            for (int ai = 0; ai < 2; ++ai)
#pragma unroll
                for (int m = 0; m < 4; ++m) { const unsigned rowb_ = tb + (unsigned)(((row0 + ai * HALF + m * 16) * 512 + col0) * 2);
#pragma unroll
                    for (int bj = 0; bj < 2; ++bj) { const f32x4 v0 = acc[ai][bj][m][0], v1 = acc[ai][bj][m][1];
                        u32x4 w; w.x = cvt_pk_bf16(v0[0], v0[1]); w.y = cvt_pk_bf16(v0[2], v0[3]); w.z = cvt_pk_bf16(v1[0], v1[1]); w.w = cvt_pk_bf16(v1[2], v1[3]);
                        store16_wt(outr, rowb_ + bj * HALF * 2, w); } }
        }
    }
};
struct EpiWo {
    static constexpr bool PERM = true, AFTER_DRAIN = true;
    const float* __restrict__ x; bf16_t* __restrict__ h1b; const float* __restrict__ bias; float* __restrict__ ssq;
    __device__ __forceinline__ void fused(f32x4 (&acc)[2][2][4][2], const Unit& u, int wr, int wc, int fr, int fq, PG8_LAS unsigned char* lds, int wid, int lane) const {
        PG8_LAS float* P = (PG8_LAS float*)lds;
        const int row0 = u.pm * BM + wr * 64 + fr, col0 = u.pn * BM + wc * 32 + 8 * fq; const __amdgpu_buffer_rsrc_t hr = wt_rsrc(h1b, 16384u * 1024u * 2u);
        f32x4 bv[2][2];
#pragma unroll
        for (int bj = 0; bj < 2; ++bj)
#pragma unroll
            for (int n = 0; n < 2; ++n) bv[bj][n] = *(const f32x4*)(bias + col0 + bj * HALF + n * 4);
#pragma unroll
        for (int ai = 0; ai < 2; ++ai) {
            f32x4 xv[4][2][2];
#pragma unroll
            for (int m = 0; m < 4; ++m)
#pragma unroll
                for (int bj = 0; bj < 2; ++bj)
#pragma unroll
                    for (int n = 0; n < 2; ++n) xv[m][bj][n] = *(const f32x4*)(x + (size_t)(row0 + ai * HALF + m * 16) * 1024 + col0 + bj * HALF + n * 4);
            asm volatile("" ::: "memory");
#pragma unroll
            for (int m = 0; m < 4; ++m) { const int row = row0 + ai * HALF + m * 16; const size_t off = (size_t)row * 1024 + col0; float s = 0.f;
#pragma unroll
                for (int bj = 0; bj < 2; ++bj) { u32x4 w;
#pragma unroll
                    for (int n = 0; n < 2; ++n) { const f32x4 h = xv[m][bj][n] + acc[ai][bj][m][n] + bv[bj][n];
                        s += (h[0] * h[0] + h[1] * h[1]) + (h[2] * h[2] + h[3] * h[3]);
                        if (n == 0) { w.x = cvt_pk_bf16(h[0], h[1]); w.y = cvt_pk_bf16(h[2], h[3]); } else { w.z = cvt_pk_bf16(h[0], h[1]); w.w = cvt_pk_bf16(h[2], h[3]); } }
                    store16_wt(hr, (unsigned)((off + bj * HALF) * 2), w); }
                s += __shfl_xor(s, 16); s += __shfl_xor(s, 32);
                if (fq == 0) P[(ai * HALF + wr * 64 + m * 16 + fr) * 4 + wc] = s; }
        }
        asm volatile("s_waitcnt lgkmcnt(0)" ::: "memory"); __builtin_amdgcn_s_barrier(); asm volatile("" ::: "memory");
        if (lane < 32) { const int r = wid * 32 + lane; const f32x4 p = *(const PG8_LAS f32x4*)(P + r * 4); ssq[(size_t)(u.pm * BM + r) * 4 + u.pn] = (p[0] + p[1]) + (p[2] + p[3]); }
    }
};
struct EpiDown {
    static constexpr bool PERM = true, AFTER_DRAIN = false;
    const bf16_t* __restrict__ h1b; float* __restrict__ out;
    __device__ __forceinline__ void operator()(const f32x4 (&acc)[2][2][4][2], const Unit& u, int wr, int wc, int fr, int fq) const {
        const int row0 = u.pm * BM + wr * 64 + fr, col0 = u.pn * BM + wc * 32 + 8 * fq;
#pragma unroll
        for (int ai = 0; ai < 2; ++ai) {
            u32x4 hv[4][2];
#pragma unroll
            for (int m = 0; m < 4; ++m)
#pragma unroll
                for (int bj = 0; bj < 2; ++bj) hv[m][bj] = *(const u32x4*)(h1b + (size_t)(row0 + ai * HALF + m * 16) * 1024 + col0 + bj * HALF);
            asm volatile("" ::: "memory");
#pragma unroll
            for (int m = 0; m < 4; ++m)
#pragma unroll
                for (int bj = 0; bj < 2; ++bj) { const u32x4 w = hv[m][bj]; float* p = out + (size_t)(row0 + ai * HALF + m * 16) * 1024 + col0 + bj * HALF;
                    f32x4 h0, h1; h0[0] = __builtin_bit_cast(float, w.x << 16); h0[1] = __builtin_bit_cast(float, w.x & 0xffff0000u); h0[2] = __builtin_bit_cast(float, w.y << 16); h0[3] = __builtin_bit_cast(float, w.y & 0xffff0000u);
                    h1[0] = __builtin_bit_cast(float, w.z << 16); h1[1] = __builtin_bit_cast(float, w.z & 0xffff0000u); h1[2] = __builtin_bit_cast(float, w.w << 16); h1[3] = __builtin_bit_cast(float, w.w & 0xffff0000u);
                    *(f32x4*)p = h0 + acc[ai][bj][m][0]; *(f32x4*)(p + 4) = h1 + acc[ai][bj][m][1]; }
        }
    }
};
__device__ __forceinline__ float dpp_prev1(float prevblk, float cur) {
    const int wrap = __builtin_amdgcn_update_dpp(0, __builtin_bit_cast(int, prevblk), 0x121, 0xf, 0xf, true);
    return __builtin_bit_cast(float, __builtin_amdgcn_update_dpp(wrap, __builtin_bit_cast(int, cur), 0x111, 0xf, 0xf, false));
}
__device__ __forceinline__ float dpp_prev2(float prevblk, float cur) {
    const int wrap = __builtin_amdgcn_update_dpp(0, __builtin_bit_cast(int, prevblk), 0x122, 0xf, 0xf, true);
    return __builtin_bit_cast(float, __builtin_amdgcn_update_dpp(wrap, __builtin_bit_cast(int, cur), 0x112, 0xf, 0xf, false));
}
__device__ __forceinline__ float silu_mul(float g, float v) { return g * __builtin_amdgcn_rcpf(1.0f + __builtin_amdgcn_exp2f(-1.4426950408889634f * g)) * v; }
struct EpiUp {
    static constexpr bool PERM = true, AFTER_DRAIN = false;
    const float* ssq; const float* cw; const float* cb; bf16_t* act; float* hraw;
    __device__ __forceinline__ void operator()(const f32x4 (&acc)[2][2][4][2], const Unit& u, int wr, int wc, int fr, int fq) const {
        const int rowb = u.pm * BM + wr * 64 + fr, jl = wc * 32 + 8 * fq, j0 = u.pn * 128 + jl;
        float rs[2][4];
#pragma unroll
        for (int ai = 0; ai < 2; ++ai)
#pragma unroll
            for (int m = 0; m < 4; ++m) { const f32x4 a = *(const f32x4*)(ssq + (size_t)(rowb + ai * HALF + m * 16) * 4);
                rs[ai][m] = __builtin_amdgcn_rsqf(((a[0] + a[1]) + (a[2] + a[3])) * (1.0f / 1024.0f) + 1e-6f); }
        unsigned pk[2][4][2][2]; const __amdgpu_buffer_rsrc_t actr = wt_rsrc(act, 16384u * 2816u * 2u);
#pragma unroll
        for (int n = 0; n < 2; ++n) {
            const int jc = j0 + 4 * n;
            const f32x4 g0 = *(const f32x4*)(cw + jc), g1 = *(const f32x4*)(cw + 5632 + jc), g2 = *(const f32x4*)(cw + 2 * 5632 + jc), gb = *(const f32x4*)(cb + jc);
            const f32x4 v0 = *(const f32x4*)(cw + 2816 + jc), v1 = *(const f32x4*)(cw + 5632 + 2816 + jc), v2 = *(const f32x4*)(cw + 2 * 5632 + 2816 + jc), vb = *(const f32x4*)(cb + 2816 + jc);
#pragma unroll
            for (int ai = 0; ai < 2; ++ai) {
                f32x4 pg = {0.f, 0.f, 0.f, 0.f}, pv = {0.f, 0.f, 0.f, 0.f};
#pragma unroll
                for (int m = 0; m < 4; ++m) {
                    const f32x4 xg = acc[ai][0][m][n] * rs[ai][m], xv = acc[ai][1][m][n] * rs[ai][m];
                    float r[4];
#pragma unroll
                    for (int e = 0; e < 4; ++e) {
                        const float cg = g0[e] * dpp_prev2(pg[e], xg[e]) + g1[e] * dpp_prev1(pg[e], xg[e]) + g2[e] * xg[e] + gb[e];
                        const float cv = v0[e] * dpp_prev2(pv[e], xv[e]) + v1[e] * dpp_prev1(pv[e], xv[e]) + v2[e] * xv[e] + vb[e];
                        r[e] = silu_mul(cg, cv); }
                    pk[ai][m][n][0] = cvt_pk_bf16(r[0], r[1]); pk[ai][m][n][1] = cvt_pk_bf16(r[2], r[3]);
                    if ((m == 0 && fr < 2) || (m == 3 && fr >= 14)) {
                        const int row = rowb + ai * HALF + m * 16; const int slot = (m == 0) ? 2 + fr : fr - 14;
                        float* hp = hraw + ((size_t)(row >> 6) * 4 + slot) * 5632 + u.pn * 256 + jl + 4 * n;
                        *(f32x4*)hp = xg; *(f32x4*)(hp + 128) = xv; }
                    pg = xg; pv = xv; } } }
#pragma unroll
        for (int ai = 0; ai < 2; ++ai)
#pragma unroll
            for (int m = 0; m < 4; ++m) { if (m == 0 && fr < 2) continue;
                u32x4 w; w.x = pk[ai][m][0][0]; w.y = pk[ai][m][0][1]; w.z = pk[ai][m][1][0]; w.w = pk[ai][m][1][1];
                store16_wt(actr, (unsigned)(((rowb + ai * HALF + m * 16) * 2816 + j0) * 2), w); }
    }
};

template <class Epi, class Sched, bool ALIGN_EPI = false, bool SP2 = false>
__device__ __forceinline__ void gemm_phase(PG8_LAS unsigned char* lds, const Gemm g, const Sched& S, const Epi& E) {
    int tid_ = threadIdx.x; asm volatile("" : "+v"(tid_));
    const int tid = tid_, wid = __builtin_amdgcn_readfirstlane(tid >> 6), lane = tid & 63, wr = wid >> 2, wc = wid & 3, fr = lane & 15, fq = lane >> 4;
    const int K = g.K, nt = K / BK;
    unsigned voffA[2], voffB[2];
#pragma unroll
    for (int i = 0; i < 2; ++i) { int R, C; stage_rc(tid * 16 + i * 8192, R, C); const int Rb = Epi::PERM ? ((R & ~31) + perm32(R & 31)) : R;
        voffA[i] = (unsigned)(R * K + C) * 2u; voffB[i] = (unsigned)(Rb * K + C) * 2u; }
    const size_t kstep = (size_t)(BK * 2);
    const size_t hstep = (size_t)HALF * K * 2;
    const size_t tstep = 2 * hstep;
    const unsigned ldsw = (unsigned)wid * 1024u;
    const int aoff = lds_byte(wr * 64 + fr, fq * 8), boff = lds_byte(wc * 32 + fr, fq * 8);
#define PG8_SA(b, h) (((b) * 2 + (h)) * HTB)
#define PG8_SB(b, h) ((4 + (b) * 2 + (h)) * HTB)
#define PG8_STAGE(bufoff, gbase, voff) do { _Pragma("unroll") for (int _i = 0; _i < 2; ++_i) \
        __builtin_amdgcn_global_load_lds((const unsigned*)((const char*)(gbase) + (voff)[_i]), (PG8_LAS unsigned*)(lds + (bufoff) + ldsw + _i * 8192), 16, 0, 0); } while (0)
#define PG8_LDA(dst, b, h) do { _Pragma("unroll") for (int m = 0; m < 4; ++m) _Pragma("unroll") for (int k = 0; k < 2; ++k) dst[m][k] = *(const PG8_LAS bf16x8*)(lds + PG8_SA(b, h) + aoff + m * 2048 + k * 1024); } while (0)
#define PG8_LDB(dst, b, h) do { _Pragma("unroll") for (int n = 0; n < 2; ++n) _Pragma("unroll") for (int k = 0; k < 2; ++k) dst[n][k] = *(const PG8_LAS bf16x8*)(lds + PG8_SB(b, h) + boff + n * 2048 + k * 1024); } while (0)
#define PG8_MMA(ai, bj, At, Bt) do { __builtin_amdgcn_s_setprio(1); _Pragma("unroll") for (int m = 0; m < 4; ++m) _Pragma("unroll") for (int n = 0; n < 2; ++n) _Pragma("unroll") for (int k = 0; k < 2; ++k) \
        acc[ai][bj][m][n] = __builtin_amdgcn_mfma_f32_16x16x32_bf16(Bt[n][k], At[m][k], acc[ai][bj][m][n], 0, 0, 0); __builtin_amdgcn_s_setprio(0); } while (0)
#define PG8_WAIT_V(n) asm volatile("s_waitcnt vmcnt(" #n ")" ::: "memory")
#define PG8_WAIT_L(n) asm volatile("s_waitcnt lgkmcnt(" #n ")" ::: "memory")
#define PG8_BAR __builtin_amdgcn_s_barrier()
#define PG8_SCHED __builtin_amdgcn_sched_barrier(0)
    Unit cur, nxt; int ui = 0;
    if (!S.next(0, cur)) return;
    f32x4 acc[2][2][4][2];
#pragma unroll
    for (int a = 0; a < 2; ++a)
#pragma unroll
        for (int b = 0; b < 2; ++b)
#pragma unroll
            for (int m = 0; m < 4; ++m)
#pragma unroll
                for (int n = 0; n < 2; ++n) acc[a][b][m][n] = (f32x4){0.f, 0.f, 0.f, 0.f};
    bf16x8 At[4][2], B0[2][2], B1[2][2];
    const char* cA = (const char*)g.A + (size_t)cur.pm * tstep; const char* cB = (const char*)g.Bt + (size_t)cur.pn * tstep;
    S.a_ready(cur);
    if constexpr (SP2) {
        PG8_STAGE(PG8_SB(0, 0), cB, voffB); PG8_STAGE(PG8_SB(0, 1), cB + hstep, voffB); PG8_STAGE(PG8_SA(0, 0), cA, voffA); PG8_STAGE(PG8_SA(0, 1), cA + hstep, voffA);
        if (wr == 1) PG8_BAR;
        PG8_WAIT_V(2); PG8_BAR;
        PG8_STAGE(PG8_SB(1, 0), cB + kstep, voffB); PG8_STAGE(PG8_SA(1, 0), cA + kstep, voffA); PG8_STAGE(PG8_SB(1, 1), cB + hstep + kstep, voffB);
        PG8_WAIT_V(6); PG8_BAR;
    } else {
        PG8_STAGE(PG8_SB(0, 0), cB, voffB); PG8_STAGE(PG8_SA(0, 0), cA, voffA); PG8_STAGE(PG8_SB(0, 1), cB + hstep, voffB); PG8_STAGE(PG8_SA(0, 1), cA + hstep, voffA);
        if (wr == 1) PG8_BAR;
        PG8_WAIT_V(4); PG8_BAR;
        PG8_STAGE(PG8_SB(1, 0), cB + kstep, voffB); PG8_STAGE(PG8_SA(1, 0), cA + kstep, voffA); PG8_STAGE(PG8_SB(1, 1), cB + hstep + kstep, voffB);
        PG8_WAIT_V(6); PG8_BAR;
    }
    for (;;) {
        const bool has_next = S.next(ui + 1, nxt);
        const char* nA = has_next ? (const char*)g.A + (size_t)nxt.pm * tstep : cA; const char* nB = has_next ? (const char*)g.Bt + (size_t)nxt.pn * tstep : cB;
        for (int t = 0; t < nt; t += 2) {
            const bool last = (t == nt - 2);
            const char* a1 = cA + (size_t)(t + 1) * kstep;
            const char* a2 = last ? nA : cA + (size_t)(t + 2) * kstep; const char* b2 = last ? nB : cB + (size_t)(t + 2) * kstep;
            const char* a3 = a2 + kstep; const char* b3 = b2 + kstep;
            if (last && has_next) S.a_ready(nxt);
            if constexpr (SP2) {
            PG8_LDB(B0, 0, 0); PG8_LDB(B1, 0, 1); PG8_SCHED; PG8_LDA(At, 0, 0); PG8_STAGE(PG8_SA(1, 1), a1 + hstep, voffA);
            PG8_WAIT_V(8); PG8_WAIT_L(0); PG8_BAR; PG8_MMA(0, 0, At, B0); PG8_MMA(0, 1, At, B1); PG8_BAR; PG8_SCHED;
            PG8_LDA(At, 0, 1); PG8_STAGE(PG8_SB(0, 0), b2, voffB); PG8_STAGE(PG8_SB(0, 1), b2 + hstep, voffB); PG8_STAGE(PG8_SA(0, 0), a2, voffA);
            PG8_WAIT_V(8); PG8_WAIT_L(0); PG8_BAR; PG8_MMA(1, 0, At, B0); PG8_MMA(1, 1, At, B1); PG8_BAR; PG8_SCHED;
            PG8_LDB(B0, 1, 0); PG8_LDB(B1, 1, 1); PG8_SCHED; PG8_LDA(At, 1, 0); PG8_STAGE(PG8_SA(0, 1), a2 + hstep, voffA);
            PG8_WAIT_V(8); PG8_WAIT_L(0); PG8_BAR; PG8_MMA(0, 0, At, B0); PG8_MMA(0, 1, At, B1); PG8_BAR; PG8_SCHED;
            PG8_LDA(At, 1, 1); PG8_STAGE(PG8_SB(1, 0), b3, voffB); PG8_STAGE(PG8_SB(1, 1), b3 + hstep, voffB); PG8_STAGE(PG8_SA(1, 0), a3, voffA);
            PG8_WAIT_V(8); PG8_WAIT_L(0); PG8_BAR; PG8_MMA(1, 0, At, B0); PG8_MMA(1, 1, At, B1); PG8_BAR; PG8_SCHED;
            } else {
            PG8_LDB(B0, 0, 0); PG8_SCHED; PG8_LDA(At, 0, 0); PG8_STAGE(PG8_SA(1, 1), a1 + hstep, voffA);
            PG8_WAIT_L(8); PG8_BAR; PG8_WAIT_L(0); PG8_MMA(0, 0, At, B0); PG8_BAR; PG8_SCHED;
            PG8_LDB(B1, 0, 1); PG8_STAGE(PG8_SB(0, 0), b2, voffB);
            PG8_BAR; PG8_WAIT_L(0); PG8_MMA(0, 1, At, B1); PG8_BAR;
            PG8_LDA(At, 0, 1); PG8_STAGE(PG8_SA(0, 0), a2, voffA);
            PG8_BAR; PG8_WAIT_L(0); PG8_MMA(1, 0, At, B0); PG8_BAR; PG8_SCHED;
            PG8_STAGE(PG8_SB(0, 1), b2 + hstep, voffB);
            PG8_WAIT_V(6); PG8_BAR; PG8_MMA(1, 1, At, B1); PG8_BAR;
            PG8_LDB(B0, 1, 0); PG8_SCHED; PG8_LDA(At, 1, 0); PG8_STAGE(PG8_SA(0, 1), a2 + hstep, voffA);
            PG8_WAIT_L(8); PG8_BAR; PG8_WAIT_L(0); PG8_MMA(0, 0, At, B0); PG8_BAR; PG8_SCHED;
            PG8_LDB(B1, 1, 1); PG8_STAGE(PG8_SB(1, 0), b3, voffB);
            PG8_BAR; PG8_WAIT_L(0); PG8_MMA(0, 1, At, B1); PG8_BAR;
            PG8_LDA(At, 1, 1); PG8_STAGE(PG8_SA(1, 0), a3, voffA);
            PG8_BAR; PG8_WAIT_L(0); PG8_MMA(1, 0, At, B0); PG8_BAR; PG8_SCHED;
            PG8_STAGE(PG8_SB(1, 1), b3 + hstep, voffB);
            PG8_WAIT_V(6); PG8_BAR; PG8_MMA(1, 1, At, B1); PG8_BAR;
            }
        }
        if constexpr (ALIGN_EPI) { if (wr == 0) PG8_BAR; }
        if constexpr (!Epi::AFTER_DRAIN) { E(acc, cur, wr, wc, fr, fq); S.done(cur); }
        if (!has_next) break;
#pragma unroll
        for (int a = 0; a < 2; ++a)
#pragma unroll
            for (int b = 0; b < 2; ++b)
#pragma unroll
                for (int m = 0; m < 4; ++m)
#pragma unroll
                    for (int n = 0; n < 2; ++n) acc[a][b][m][n] = (f32x4){0.f, 0.f, 0.f, 0.f};
        cur = nxt; cA = nA; cB = nB; ++ui;
        if constexpr (ALIGN_EPI) { if (wr == 1) PG8_BAR; }
    }
    PG8_WAIT_V(0);
    if constexpr (!ALIGN_EPI) { if (wr == 0) PG8_BAR; }
    PG8_BAR;
    if constexpr (Epi::AFTER_DRAIN) { E.fused(acc, cur, wr, wc, fr, fq, lds, wid, lane); S.done(cur); }
#undef PG8_SA
#undef PG8_SB
#undef PG8_STAGE
#undef PG8_LDA
#undef PG8_LDB
#undef PG8_MMA
#undef PG8_WAIT_V
#undef PG8_WAIT_L
#undef PG8_BAR
#undef PG8_SCHED
}
}

#ifndef PG8_SP2
#define PG8_SP2 true
#endif
#ifndef PG8_ALIGN
#define PG8_ALIGN true
#endif
#include <hip/hip_bf16.h>
#include <cmath>
namespace attn_body {
using bf16=__hip_bfloat16;
using bf16x8=__attribute__((ext_vector_type(8)))short;
using s16x4=__attribute__((ext_vector_type(4)))short;
using f32x16=__attribute__((ext_vector_type(16)))float;
using u32x4=__attribute__((ext_vector_type(4)))unsigned;
constexpr int BATCH=2,NHEAD=8,SEQ=8192,D=64,PQ=512,PVV=512,PO=1024,KPADR=64,KDEAD=48;
constexpr int NW=8,QBLK=32,QB=QBLK*NW,KVBLK=64,NQB=SEQ/QB;
constexpr int ATTN_UNIT_ROWS=QB;
__device__ __forceinline__ int crow(int r,int hi){return (r&3)+8*(r>>2)+4*hi;}
#define SBAR() __builtin_amdgcn_sched_barrier(0)
__device__ __forceinline__ void cmask(f32x16&p0,f32x16&p1,int jb,int qrel,int hi){
  const float NEG=-INFINITY; int kb=64*jb+4*hi;
  #pragma unroll
  for(int r=0;r<16;++r){int kv=kb+(r&3)+8*(r>>2); if(kv>qrel)p0[r]=NEG; if(kv+32>qrel)p1[r]=NEG;}
}

constexpr int NSLOT=3, SLOTB=8192, VSLOTB=2*SLOTB;
constexpr int LDS_K=0, LDS_V=NSLOT*SLOTB, LDS_WS=LDS_V+NSLOT*VSLOTB, LDS_OST=LDS_WS+NW*64*4, LDS_BYTES=LDS_OST+NW*4096;
constexpr float C2=0.125f*1.4426950408889634f;
__device__ __forceinline__ void glds16(const void*gsrc,unsigned lds_dst){unsigned keep;
  asm volatile("s_mov_b32 %0, m0\n\ts_mov_b32 m0, %2\n\ts_nop 0\n\tglobal_load_lds_dwordx4 %1, off\n\ts_mov_b32 m0, %0":"=&s"(keep):"v"(gsrc),"s"(lds_dst):"memory");}
__device__ __forceinline__ float max3f(float a,float b,float c){float r;asm("v_max3_f32 %0, %1, %2, %3":"=v"(r):"v"(a),"v"(b),"v"(c));return r;}
__device__ __forceinline__ float max2f(float a,float b){float r;asm("v_max_f32_e32 %0, %1, %2":"=v"(r):"v"(a),"v"(b));return r;}
__device__ __forceinline__ float fadd_s(float a,float b){float r;asm("v_add_f32_e32 %0, %1, %2":"=v"(r):"v"(a),"v"(b));return r;}
__device__ __forceinline__ float fsub_s(float a,float b){float r;asm("v_sub_f32_e32 %0, %1, %2":"=v"(r):"v"(a),"v"(b));return r;}
typedef float f32x2_t __attribute__((ext_vector_type(2))); typedef __bf16 bf16x2_t __attribute__((ext_vector_type(2)));
__device__ __forceinline__ unsigned cvtpk_s(float lo,float hi){f32x2_t v={lo,hi};bf16x2_t b=__builtin_convertvector(v,bf16x2_t);return __builtin_bit_cast(unsigned,b);}
#define WAIT_BAR(N) asm volatile("s_waitcnt vmcnt(" #N ") lgkmcnt(0)\n\ts_barrier":::"memory")

__device__ __forceinline__ void qkt(f32x16&p0,f32x16&p1,const char*Kslot,const bf16x8*qr,const f32x16&negm,int r32,int hi){
  const char*kb=Kslot+hi*1024+r32*16;
  #pragma unroll
  for(int d0=0;d0<4;++d0){
    const bf16x8 b0=*reinterpret_cast<const bf16x8*>(kb+d0*2048);
    const bf16x8 b1=*reinterpret_cast<const bf16x8*>(kb+d0*2048+512);
    if(d0==0){p0=__builtin_amdgcn_mfma_f32_32x32x16_bf16(b0,qr[0],negm,0,0,0);p1=__builtin_amdgcn_mfma_f32_32x32x16_bf16(b1,qr[0],negm,0,0,0);}
    else{p0=__builtin_amdgcn_mfma_f32_32x32x16_bf16(b0,qr[d0],p0,0,0,0);p1=__builtin_amdgcn_mfma_f32_32x32x16_bf16(b1,qr[d0],p1,0,0,0);}}
}
typedef __attribute__((address_space(3))) const char* lds_cptr;
typedef short v4i16_t __attribute__((ext_vector_type(4)));
__device__ __forceinline__ void kload8(bf16x8*kf,lds_cptr kp){
  kf[0]=*(const __attribute__((address_space(3))) bf16x8*)(kp);      kf[1]=*(const __attribute__((address_space(3))) bf16x8*)(kp+512);
  kf[2]=*(const __attribute__((address_space(3))) bf16x8*)(kp+2048); kf[3]=*(const __attribute__((address_space(3))) bf16x8*)(kp+2560);
  kf[4]=*(const __attribute__((address_space(3))) bf16x8*)(kp+4096); kf[5]=*(const __attribute__((address_space(3))) bf16x8*)(kp+4608);
  kf[6]=*(const __attribute__((address_space(3))) bf16x8*)(kp+6144); kf[7]=*(const __attribute__((address_space(3))) bf16x8*)(kp+6656);
}
__device__ __forceinline__ void kload2(bf16x8*kf,lds_cptr kp,int j){ kf[2*j]=*(const __attribute__((address_space(3))) bf16x8*)(kp+j*2048); kf[2*j+1]=*(const __attribute__((address_space(3))) bf16x8*)(kp+j*2048+512); }
__device__ __forceinline__ s16x4 vtr(lds_cptr p){ return __builtin_bit_cast(s16x4,__builtin_amdgcn_ds_read_tr16_b64_v4i16((__attribute__((address_space(3))) v4i16_t*)p)); }
__device__ __forceinline__ float rowmax(const f32x16&p0,const f32x16&p1){
  float a=max3f(p0[0],p0[1],p1[0]),b=max3f(p0[2],p0[3],p1[1]);a=max3f(a,p1[2],p1[3]);
  #pragma unroll
  for(int r=4;r<16;r+=4){a=max3f(a,p0[r],p0[r+1]);b=max3f(b,p0[r+2],p0[r+3]);a=max3f(a,p1[r],p1[r+1]);b=max3f(b,p1[r+2],p1[r+3]);}
  const float m=max2f(a,b);
  auto rr=__builtin_amdgcn_permlane32_swap(__float_as_uint(m),__float_as_uint(m),false,false);
  return max2f(__uint_as_float(rr[0]),__uint_as_float(rr[1]));
}
__device__ __forceinline__ void pv(f32x16*o,int vb,bf16x8 pa0,bf16x8 pa1,bf16x8 pa2,bf16x8 pa3){
  #pragma unroll
  for(int d0=0;d0<4;++d0){s16x4 lo[4],hi[4];
    #pragma unroll
    for(int ks=0;ks<4;++ks){
      asm volatile("ds_read_b64_tr_b16 %0,%1 offset:%c2":"=&v"(lo[ks]):"v"(vb),"i"(d0*4096+ks*1024):"memory");
      asm volatile("ds_read_b64_tr_b16 %0,%1 offset:%c2":"=&v"(hi[ks]):"v"(vb),"i"(d0*4096+ks*1024+512):"memory");}
    asm volatile("s_waitcnt lgkmcnt(0)":::"memory");SBAR();
    #define PK(k) (bf16x8){lo[k][0],lo[k][1],lo[k][2],lo[k][3],hi[k][0],hi[k][1],hi[k][2],hi[k][3]}
    o[d0]=__builtin_amdgcn_mfma_f32_32x32x16_bf16(pa0,PK(0),o[d0],0,0,0);
    o[d0]=__builtin_amdgcn_mfma_f32_32x32x16_bf16(pa1,PK(1),o[d0],0,0,0);
    o[d0]=__builtin_amdgcn_mfma_f32_32x32x16_bf16(pa2,PK(2),o[d0],0,0,0);
    o[d0]=__builtin_amdgcn_mfma_f32_32x32x16_bf16(pa3,PK(3),o[d0],0,0,0);
    #undef PK
  }
}

#ifndef ATTN_STORE16
#define ATTN_STORE16(p,v) (*(u32x4*)(p)=(v))
#endif
template<int THRL> __device__ __forceinline__ void attn_unit(int b,int h,int qb,const bf16*Q,const bf16*__restrict__ K,const bf16*__restrict__ V,bf16*O,char*shm){
  const int hq=(h>>1)*128+(h&1)*64, hv=(h>>1)*128, ho=h*128;
  int tid_=threadIdx.x; asm volatile("":"+v"(tid_));
  const int tid=tid_,lane=tid&63,r32=lane&31,hi=lane>>5; const int wid=__builtin_amdgcn_readfirstlane(tid>>6);
  const long rowbase=(long)b*SEQ; const int q0=qb*QB;
  const bf16*Qw=Q+(rowbase+q0+wid*QBLK)*PQ+hq;
  const long kvbase=(long)b*(SEQ+KPADR);
  const bf16*Kh=K+kvbase*PQ+hq,*Vh=V+kvbase*PVV+hv;
  const unsigned lds0=(unsigned)(uintptr_t)shm;
  float*wsf=(float*)(shm+LDS_WS)+wid*64;
  const bf16*ksrc=Kh+(long)lane*PQ+wid*8;
  const bf16*vsrc=Vh+(long)(16*(wid&3)+(lane>>2))*PVV+(wid>>2)*32+(lane&3)*8;
  const unsigned kdst=lds0+LDS_K+wid*1024, vdst=lds0+LDS_V+wid*1024;
  #define DMA_K(t,slot) glds16(ksrc+(long)(t)*KVBLK*PQ,(unsigned)__builtin_amdgcn_readfirstlane(kdst+(slot)))
  #define DMA_V(t,slot) do{ glds16(vsrc+(long)(t)*KVBLK*PVV,(unsigned)__builtin_amdgcn_readfirstlane(vdst+2*(slot))); glds16(vsrc+(long)(t)*KVBLK*PVV+64,(unsigned)__builtin_amdgcn_readfirstlane(vdst+2*(slot)+2*4096)); }while(0)
  const int vb0=(int)(lds0+LDS_V)+((lane>>4)&1)*32+(lane&3)*8+(4*hi+((lane&15)>>2))*64;
  const char*Kbase=shm+LDS_K; bf16x8 kf[8];
  const lds_cptr shm3=(lds_cptr)shm; const lds_cptr kp0=shm3+LDS_K+hi*1024+r32*16; const lds_cptr vp0=shm3+LDS_V+((lane>>4)&1)*32+(lane&3)*8+(4*hi+((lane&15)>>2))*64;
  const int NT=(q0+QB+KPADR)/KVBLK;
  DMA_K(0,0);DMA_V(0,0);DMA_K(1,SLOTB);
  bf16x8 qr[4];
  #pragma unroll
  for(int d0=0;d0<4;++d0)qr[d0]=*reinterpret_cast<const bf16x8*>(&Qw[(long)r32*PQ+d0*16+hi*8]);
  float mhat=0.f,l_reg=0.f;f32x16 o[4];o[0]=f32x16{};o[1]=f32x16{};o[2]=f32x16{};o[3]=f32x16{};const f32x16 zero16=f32x16{};
  const int qrel=wid*QBLK+r32;
  #define CMASK(P0,P1,t) do{int jb_=(t)-(NT-4); if(jb_>=0)cmask(P0,P1,jb_,qrel,hi);}while(0)
  bool resc=false;
  #define START(P0,P1) do{ const float rm=rowmax(P0,P1); resc=false; \
    { const float dl=rm; mhat=fadd_s(mhat,dl); \
      _Pragma("unroll") for(int r=0;r<16;++r){P0[r]=fsub_s(P0[r],dl);P1[r]=fsub_s(P1[r],dl);} \
    } \
    _Pragma("unroll") for(int r=0;r<16;++r)P0[r]=__builtin_amdgcn_exp2f(P0[r]); }while(0)
  #define RESC() do{ if(resc){ asm volatile("s_waitcnt lgkmcnt(0)":::"memory"); \
      _Pragma("unroll") for(int d_=0;d_<4;++d_) _Pragma("unroll") for(int r=0;r<16;++r)o[d_][r]*=wsf[crow(r,hi)]; } }while(0)
  f32x16 pA0,pA1,pB0,pB1;
  int sl_prev=0,sl_cur=0,sl_next=SLOTB;
  #define ROT() do{sl_prev=sl_cur;sl_cur=sl_next;sl_next=(sl_next==(NSLOT-1)*SLOTB)?0:sl_next+SLOTB;}while(0)
  DMA_K(2,2*SLOTB);
  WAIT_BAR(4);
  qkt(pA0,pA1,Kbase,qr,zero16,r32,hi);asm volatile("s_nop 15\n\ts_nop 7":"+v"(pA0),"+v"(pA1));CMASK(pA0,pA1,0);
  START(pA0,pA1);
  _Pragma("unroll") for(int r=0;r<16;++r)pA1[r]=__builtin_amdgcn_exp2f(pA1[r]);
  WAIT_BAR(0);
  DMA_K(3,0);DMA_V(1,SLOTB);
  ROT();
  kload8(kf,kp0+sl_cur);
  WAIT_BAR(3);
  s16x4 vlo[4],vhi[4]; u32x4 pw0,pw1,pw2,pw3;
  #define PKW(P,B) cvtpk_s(P[B],P[B+1])
  #define PAF(k) __builtin_bit_cast(bf16x8,pw##k)
  #define VFR(i) (bf16x8){vlo[i][0],vlo[i][1],vlo[i][2],vlo[i][3],vhi[i][0],vhi[i][1],vhi[i][2],vhi[i][3]}
  #define PIN(x) asm volatile("":"+v"(x))
  #define MX3(a,b,c) __builtin_fmaxf(__builtin_fmaxf((a),(b)),(c))
  #define GAPA(MF,A0,A1,A2,A3,W0,W1,PW) do{ MF; sacc+=A0; sacc+=A1; sacc+=A2; sacc+=A3; PIN(sacc); W0; W1; PIN(PW); SBAR(); }while(0)
  #define EX(v) __builtin_amdgcn_exp2f(v)
  #define GAPB(MF,X,B) do{ MF; X[B]=EX(X[B]); X[B+1]=EX(X[B+1]); X[B+2]=EX(X[B+2]); X[B+3]=EX(X[B+3]); PIN(X); SBAR(); }while(0)
  #define VRDH(i,cb,ks) do{ vlo[i]=vtr(vp_+((cb)*4096+(ks)*1024)); vhi[i]=vtr(vp_+((cb)*4096+(ks)*1024+512)); }while(0)
  #define KRD(G,j) do{ if(G){ kload2(kf,kp0+sl_next,j); SBAR(); } }while(0)
  #define GAPB2(MF,X,B) do{ MF; X[B]=EX(X[B]); X[B+1]=EX(X[B+1]); PIN(X); SBAR(); }while(0)
  #define PVM(ob,k,i) o[ob]=MFMA_(PAF(k),VFR(i),o[ob],0,0,0)
  #define MFMA_ __builtin_amdgcn_mfma_f32_32x32x16_bf16
  #define STEP(C0,C1,P0,P1,t,GK,GV,GL) do{ SBAR(); \
    const lds_cptr vp_=vp0+2*sl_prev; \
    VRDH(0,0,0); SBAR(); float sacc=(P0[0]+P0[1]); \
    GAPA(C0=MFMA_(kf[0],qr[0],zero16,0,0,0), P0[2],P0[3],P0[4],P0[5],     pw0[0]=PKW(P0,0), pw0[1]=PKW(P0,2), pw0); \
    VRDH(1,1,0); SBAR(); GAPA(C1=MFMA_(kf[1],qr[0],zero16,0,0,0), P0[6],P0[7],P0[8],P0[9],     pw0[2]=PKW(P0,4), pw0[3]=PKW(P0,6), pw0); \
    VRDH(2,0,1); SBAR(); GAPA(C0=MFMA_(kf[2],qr[1],C0,0,0,0),   P0[10],P0[11],P0[12],P0[13], pw1[0]=PKW(P0,8), pw1[1]=PKW(P0,10), pw1); \
    VRDH(3,1,1); SBAR(); GAPA(C1=MFMA_(kf[3],qr[1],C1,0,0,0),   P0[14],P0[15],P1[0],P1[1],   pw1[2]=PKW(P0,12),pw1[3]=PKW(P0,14), pw1); \
    GAPA(C0=MFMA_(kf[4],qr[2],C0,0,0,0),   P1[2],P1[3],P1[4],P1[5],     pw2[0]=PKW(P1,0), pw2[1]=PKW(P1,2), pw2); \
    GAPA(C1=MFMA_(kf[5],qr[2],C1,0,0,0),   P1[6],P1[7],P1[8],P1[9],     pw2[2]=PKW(P1,4), pw2[3]=PKW(P1,6), pw2); \
    GAPA(C0=MFMA_(kf[6],qr[3],C0,0,0,0),   P1[10],P1[11],P1[12],P1[13], pw3[0]=PKW(P1,8), pw3[1]=PKW(P1,10), pw3); \
    GAPA(C1=MFMA_(kf[7],qr[3],C1,0,0,0),   P1[14],P1[15],0.f,0.f,       pw3[2]=PKW(P1,12),pw3[3]=PKW(P1,14), pw3); \
    l_reg+=sacc; \
    if(GK){DMA_K((t)+3,sl_cur);} if(GV){DMA_V((t)+1,sl_next);} \
    _Pragma("unroll") for(int r=0;r<16;++r){C0[r]-=mhat;C1[r]-=mhat;}   \
    CMASK(C0,C1,t); \
    { float a=MX3(C0[0],C0[1],C1[0]),b=MX3(C0[2],C0[3],C1[1]); a=MX3(a,C1[2],C1[3]); \
      _Pragma("unroll") for(int r=4;r<16;r+=4){a=MX3(a,C0[r],C0[r+1]);b=MX3(b,C0[r+2],C0[r+3]);a=MX3(a,C1[r],C1[r+1]);b=MX3(b,C1[r+2],C1[r+3]);} \
      float rm=__builtin_fmaxf(a,b); { auto rr=__builtin_amdgcn_permlane32_swap(__float_as_uint(rm),__float_as_uint(rm),false,false); rm=__builtin_fmaxf(__uint_as_float(rr[0]),__uint_as_float(rr[1])); } \
      resc=false; \
      if(__builtin_expect(__any(rm>(float)THRL),0)){ const float dl=__builtin_fmaxf(rm,0.f); mhat+=dl; \
        _Pragma("unroll") for(int r=0;r<16;++r){C0[r]-=dl;C1[r]-=dl;} \
        const float f=__builtin_amdgcn_exp2f(-dl); l_reg*=f; if(hi==0)wsf[r32]=f; resc=true; } } \
    SBAR(); \
    GAPB2(PVM(0,0,0), C0,0);  VRDH(0,0,2); SBAR(); \
    GAPB2(PVM(1,0,1), C0,2);  VRDH(1,1,2); SBAR(); \
    GAPB2(PVM(0,1,2), C0,4);  VRDH(2,0,3); SBAR(); \
    GAPB2(PVM(1,1,3), C0,6);  VRDH(3,1,3); SBAR(); \
    KRD(GL,0); GAPB2(PVM(0,2,0), C0,8);  VRDH(0,2,0); SBAR(); \
    GAPB2(PVM(1,2,1), C0,10); VRDH(1,3,0); SBAR(); \
    KRD(GL,1); GAPB2(PVM(0,3,2), C0,12); VRDH(2,2,1); SBAR(); \
    GAPB2(PVM(1,3,3), C0,14); VRDH(3,3,1); SBAR(); \
    KRD(GL,2); GAPB2(PVM(2,0,0), C1,0);  VRDH(0,2,2); SBAR(); \
    GAPB2(PVM(3,0,1), C1,2);  VRDH(1,3,2); SBAR(); \
    KRD(GL,3); GAPB2(PVM(2,1,2), C1,4);  VRDH(2,2,3); SBAR(); \
    GAPB2(PVM(3,1,3), C1,6);  VRDH(3,3,3); SBAR(); \
    GAPB2(PVM(2,2,0), C1,8); \
    GAPB2(PVM(3,2,1), C1,10); \
    GAPB2(PVM(2,3,2), C1,12); \
    GAPB2(PVM(3,3,3), C1,14); \
    }while(0)
  int t=1;
  #undef CMASK
  #define CMASK(P0,P1,t) do{}while(0)
  for(;t+5<NT;t+=2){
    STEP(pB0,pB1,pA0,pA1,t,true,true,true);     WAIT_BAR(3); RESC(); ROT();
    STEP(pA0,pA1,pB0,pB1,t+1,true,true,true);   WAIT_BAR(3); RESC(); ROT();
  }
  #undef CMASK
  #define CMASK(P0,P1,t) do{int jb_=(t)-(NT-4); if(jb_>=0)cmask(P0,P1,jb_,qrel,hi);}while(0)
  #define ENDW(tt) do{ if((tt)+3<NT){WAIT_BAR(3);} else if((tt)+2<NT){WAIT_BAR(2);} else {WAIT_BAR(0);} }while(0)
  for(;t+1<NT;t+=2){
    STEP(pB0,pB1,pA0,pA1,t,(t+3<NT),(t+1<NT),(t+1<NT));       ENDW(t);   RESC(); ROT();
    STEP(pA0,pA1,pB0,pB1,t+1,(t+4<NT),(t+2<NT),(t+2<NT));     ENDW(t+1); RESC(); ROT();
  }
  { float sacc=pA0[0]+pA0[1]; _Pragma("unroll") for(int r=2;r<16;++r)sacc+=pA0[r]; _Pragma("unroll") for(int r=0;r<16;++r)sacc+=pA1[r]; l_reg+=sacc;
    pw0=(u32x4){PKW(pA0,0),PKW(pA0,2),PKW(pA0,4),PKW(pA0,6)};pw1=(u32x4){PKW(pA0,8),PKW(pA0,10),PKW(pA0,12),PKW(pA0,14)};pw2=(u32x4){PKW(pA1,0),PKW(pA1,2),PKW(pA1,4),PKW(pA1,6)};pw3=(u32x4){PKW(pA1,8),PKW(pA1,10),PKW(pA1,12),PKW(pA1,14)};
    SBAR(); pv(o,vb0+2*sl_prev,PAF(0),PAF(1),PAF(2),PAF(3)); }
  #undef PKW
  #undef PAF
  #undef VFR
  #undef PIN
  #undef MX3
  #undef GAPA
  #undef GAPB
  #undef GAPB2
  #undef PVM
  #undef MFMA_
  #undef VRDH
  #undef EX
  #undef KRD
  #undef STEP
  #undef ENDW
  {auto rr=__builtin_amdgcn_permlane32_swap(__float_as_uint(l_reg),__float_as_uint(l_reg),false,false);l_reg=__uint_as_float(rr[0])+__uint_as_float(rr[1]);}
  l_reg-=(float)KDEAD*__builtin_amdgcn_exp2f(-mhat);
  if(hi==0)wsf[32+r32]=l_reg;asm volatile("s_waitcnt lgkmcnt(0)":::"memory");
  float rli[16];
  #pragma unroll
  for(int r=0;r<16;++r)rli[r]=__builtin_amdgcn_rcpf(wsf[32+crow(r,hi)]);
  const __amdgpu_buffer_rsrc_t orsrc=__builtin_amdgcn_make_buffer_rsrc(O,0,(int)(2u*SEQ*PO*2u),0x00020000);
  { int le=threadIdx.x&63; asm volatile("":"+v"(le)); const int lane=le; int sbase=4*(le>>5)*64+(le&31);
    bf16*stg=(bf16*)(shm+LDS_OST)+wid*2048;
    #pragma unroll
    for(int ps=0;ps<2;++ps){
      #pragma unroll
      for(int r=0;r<16;++r){
        #pragma unroll
        for(int d0=0;d0<2;++d0)stg[sbase+((r&3)+8*(r>>2))*64+d0*32]=__float2bfloat16(o[2*ps+d0][r]*rli[r]);}
      asm volatile("s_waitcnt lgkmcnt(0)":::"memory");
      #pragma unroll
      for(int i=0;i<4;++i){const int row=i*8+(lane>>3),ch=lane&7; const u32x4 v=*(const u32x4*)(stg+row*64+ch*8); __builtin_amdgcn_raw_buffer_store_b128(v,orsrc,(unsigned)(((rowbase+q0+wid*QBLK+row)*PO+ho+ps*64+ch*8)*2),0,16);}
      asm volatile("s_waitcnt lgkmcnt(0)":::"memory"); } }
  asm volatile("s_waitcnt lgkmcnt(0)\n\ts_barrier":::"memory");
  #undef DMA_K
  #undef DMA_V
  #undef CMASK
  #undef START
  #undef RESC
  #undef ROT
}
constexpr int ATTN_LDS_BYTES=LDS_BYTES;
struct AttnTensors { const bf16* Q; const bf16* K; const bf16* V; bf16* O; };
struct AttnUnit { int bh; int qb; };
struct StaticOrder {
  int vcu;
  __device__ __forceinline__ explicit StaticOrder(int grid,int block):vcu((block%8)*(grid/8)+block/8){}
  __device__ __forceinline__ bool next(int i,AttnUnit&u)const{ if(i>=2)return false; const int s=vcu&15; u.bh=vcu>>4; u.qb=(i==0)?s:31-s; return true; }
  __device__ __forceinline__ void a_ready(const AttnUnit&)const{}
  __device__ __forceinline__ void done(const AttnUnit&)const{}
};
template<class Sched,int THRL=8> __device__ __forceinline__ void attn_phase(char*lds,const AttnTensors&T,const Sched&S){
  AttnUnit u;
  for(int i=0;S.next(i,u);++i){ S.a_ready(u); attn_unit<THRL>(u.bh/NHEAD,u.bh%NHEAD,u.qb,T.Q,T.K,T.V,T.O,lds); S.done(u); }
}
#undef SBAR
#undef WAIT_BAR
}
#include <hip/hip_cooperative_groups.h>
namespace cg = cooperative_groups;
constexpr int NWAVES = 8;
constexpr int T = 8192, D = 1024, NMETA = 16, MR = 2 * T  , MA = MR + NMETA  ;
constexpr int NIN = 2048, DFF = 2816, NUP = 2 * DFF;
constexpr int KPAD = 64, TP = T + KPAD;
constexpr float EPS = 1e-6f;
constexpr float LAM_INIT = 0.2f;
constexpr size_t MiB = 1u << 20;
constexpr size_t WS_WIN = 2 * MiB, WS_WO = 6 * MiB, WS_WUP = 8 * MiB, WS_WDN = 19 * MiB;
constexpr size_t WS_BPART = 25 * MiB, WS_BEFF = WS_BPART + 65536, WS_H1M = WS_BEFF + 4096, WS_UM = WS_H1M + 65536;
constexpr size_t WS_SSQ = 26 * MiB, WS_LSE = 27 * MiB;
constexpr size_t WS_XN = 28 * MiB;
constexpr size_t WS_MIX = 60 * MiB;
constexpr size_t WS_HRAW = 93 * MiB;
constexpr size_t WS_U = 116 * MiB, SPLIT_STRIDE_B = 17 * MiB;
constexpr size_t WS_Q = WS_U + SPLIT_STRIDE_B, WS_K = WS_Q + SPLIT_STRIDE_B, WS_V = WS_K + SPLIT_STRIDE_B;
constexpr size_t WS_O = 184 * MiB;
constexpr size_t WS_ACT = 116 * MiB;
constexpr size_t WS_END = 216 * MiB;
static_assert(WS_UM + 16 * NUP * 4 <= WS_SSQ && WS_HRAW + (size_t)256 * 4 * NUP * 4 <= WS_U && WS_ACT + (size_t)MR * DFF * 2 <= WS_END && WS_MIX + (size_t)MA * D * 2 <= WS_HRAW && (size_t)2 * TP * 512 * 2 <= SPLIT_STRIDE_B, "ws map");
constexpr int LDS_BYTES = 147456, RING_OFF = 0;

#define LAS __attribute__((address_space(3)))
typedef unsigned short bf16;
typedef unsigned v4u __attribute__((ext_vector_type(4)));
typedef float f32x4 __attribute__((ext_vector_type(4)));
typedef short bf16x8 __attribute__((ext_vector_type(8)));
__device__ __forceinline__ unsigned f2bf(float f) { unsigned u = __builtin_bit_cast(unsigned, f); return (u + 0x7fffu + ((u >> 16) & 1u)) >> 16; }
__device__ __forceinline__ unsigned pk2(float lo, float hi) { return f2bf(lo) | (f2bf(hi) << 16); }
__device__ __forceinline__ float bflo(unsigned w) { return __builtin_bit_cast(float, w << 16); }
__device__ __forceinline__ float bfhi(unsigned w) { return __builtin_bit_cast(float, w & 0xffff0000u); }
__device__ __forceinline__ void unpack8(const v4u w, float (&f)[8]) { f[0] = bflo(w.x); f[1] = bfhi(w.x); f[2] = bflo(w.y); f[3] = bfhi(w.y); f[4] = bflo(w.z); f[5] = bfhi(w.z); f[6] = bflo(w.w); f[7] = bfhi(w.w); }
__device__ __forceinline__ float wave_sum(float v) {
#pragma unroll
    for (int o = 1; o < 64; o <<= 1) v += __shfl_xor(v, o);
    return v;
}
typedef __attribute__((address_space(1))) unsigned gu32;
#define XB_TMO      128
#define XB_XCNT(j)  (256  + 64 * (j))
#define XB_XSUB(j)  (1280 + 64 * (j))
#define XB_XGEN(j)  (2304 + 64 * (j))
#define XB_TOP      3328
#define XB_TOPGEN   3392
#define XCD_BAR_WORDS 3456
#define XB_SPIN_CAP (1u << 18)

__device__ __forceinline__ unsigned xb_ld(unsigned* p)              { return __hip_atomic_load(p, __ATOMIC_RELAXED, __HIP_MEMORY_SCOPE_AGENT); }
__device__ __forceinline__ unsigned xb_add(unsigned* p, unsigned v) { return __hip_atomic_fetch_add(p, v, __ATOMIC_RELAXED, __HIP_MEMORY_SCOPE_AGENT); }
__device__ __forceinline__ unsigned xb_xcc_id() { return (unsigned)__builtin_amdgcn_s_getreg((3 << 11) | 20) & 0xFu; }
#define XB_SPIN(cond, bar) do { unsigned _sp = 0; while (cond) { __builtin_amdgcn_s_sleep(1); \
    if ((++_sp & 255u) == 0u) { if (xb_ld(&(bar)[XB_TMO])) break; if (_sp > XB_SPIN_CAP) { atomicAdd(&(bar)[XB_TMO], 1u); break; } } } } while (0)

struct XcdBarrier {
    unsigned* bar; unsigned x;
    volatile LAS unsigned* st;
};

__device__ __forceinline__ XcdBarrier xcd_barrier_post(unsigned* bar, volatile LAS unsigned* st) {
    XcdBarrier b; b.bar = bar; b.x = xb_xcc_id(); b.st = st;
    if (threadIdx.x == 0) (void)xb_add(&bar[XB_XCNT(b.x)], 1u);
    return b;
}
__device__ __forceinline__ void xcd_barrier_complete(unsigned* bar, unsigned x, unsigned& nloc, unsigned& nx) {
    const unsigned G = gridDim.x * gridDim.y * gridDim.z;
    unsigned sum, cnt, mine, sp = 0u;
    for (;;) {
        sum = 0u; cnt = 0u; mine = 0u;
#pragma unroll
        for (unsigned j = 0; j < 16; ++j) { const unsigned c = xb_ld(&bar[XB_XCNT(j)]); sum += c; cnt += (c > 0u) ? 1u : 0u; mine = (j == x) ? c : mine; }
        if (sum == G) break;
        __builtin_amdgcn_s_sleep(1);
        if ((++sp & 255u) == 0u) { if (xb_ld(&bar[XB_TMO])) break; if (sp > XB_SPIN_CAP) { atomicAdd(&bar[XB_TMO], 1u); break; } }
    }
    nloc = mine > 0u ? mine : 1u; nx = cnt > 0u ? cnt : 1u;
}

__device__ __forceinline__ void xcd_barrier(const XcdBarrier& b) {
    asm volatile("s_waitcnt vmcnt(0)" ::: "memory");
    __syncthreads();
    if (threadIdx.x == 0) {
        unsigned* bar = b.bar;
        __builtin_amdgcn_s_waitcnt(0);
        unsigned nloc = b.st[0], nx = b.st[1];
        if (nloc == 0u) { xcd_barrier_complete(bar, b.x, nloc, nx); b.st[0] = nloc; b.st[1] = nx; }
        const unsigned old = xb_add(&bar[XB_XSUB(b.x)], 1u);
        const unsigned gen = old / nloc;
        if (old + 1u == (gen + 1u) * nloc) {
            __builtin_amdgcn_fence(__ATOMIC_RELEASE, "agent");
            asm volatile("s_waitcnt vmcnt(0)" ::: "memory");
            const unsigned og = xb_add(&bar[XB_TOP], 1u);
            const unsigned tg = og / nx;
            if (og + 1u == (tg + 1u) * nx) xb_add(&bar[XB_TOPGEN], 1u);
            else XB_SPIN(xb_ld(&bar[XB_TOPGEN]) == tg, bar);
            __builtin_amdgcn_fence(__ATOMIC_ACQUIRE, "agent");
            xb_add(&bar[XB_XGEN(b.x)], 1u);
            asm volatile("s_waitcnt vmcnt(0)" ::: "memory");
        } else {
            XB_SPIN(xb_ld(&bar[XB_XGEN(b.x)]) == gen, bar);
            __builtin_amdgcn_fence(__ATOMIC_ACQUIRE, "agent");
            asm volatile("s_waitcnt vmcnt(0)" ::: "memory");
        }
    }
    __syncthreads();
}

constexpr size_t WS_BAR = 16384;
constexpr int MISC_OFF = 131072 + 320;
struct Args { const float* in[20]; float* out; unsigned char* ws; };
enum { I_X = 0, I_META, I_GMIX, I_WIN, I_WPOOL, I_BPOOL, I_PSCALE, I_QG, I_KG, I_LQ1, I_LK1, I_LQ2, I_LK2, I_SUBG, I_WOUT, I_GFFN, I_WUP, I_CONVW, I_CONVB, I_WDOWN };

__device__ __forceinline__ void transpose_item(const float* W, int N, int ksrc0, int n0, bf16* WT, int ldt, int drow0, int kdst0, LAS float* scr, int lane, const float* kgain = nullptr) {
    float tv[32];
#pragma unroll
    for (int i = 0; i < 32; ++i) tv[i] = W[(size_t)(ksrc0 + 2 * i + (lane >> 5)) * N + n0 + (lane & 31)];
    if (kgain) {
#pragma unroll
        for (int i = 0; i < 32; ++i) tv[i] *= kgain[ksrc0 + 2 * i + (lane >> 5)]; }
#pragma unroll
    for (int i = 0; i < 32; ++i) scr[(2 * i + (lane >> 5)) * 33 + (lane & 31)] = tv[i];
    asm volatile("s_waitcnt lgkmcnt(0)" ::: "memory");
    const int c = lane & 7; const __amdgpu_buffer_rsrc_t wtr = __builtin_amdgcn_make_buffer_rsrc(WT, 0, 16 << 20, 0x00020000);
#pragma unroll
    for (int j = 0; j < 4; ++j) { const int n = (lane >> 3) + 8 * j; const LAS float* s = scr + (8 * c) * 33 + n;
        v4u o; o.x = pk2(s[0 * 33], s[1 * 33]); o.y = pk2(s[2 * 33], s[3 * 33]); o.z = pk2(s[4 * 33], s[5 * 33]); o.w = pk2(s[6 * 33], s[7 * 33]);
        __builtin_amdgcn_raw_buffer_store_b128(o, wtr, (unsigned)(((drow0 + n) * ldt + kdst0 + 8 * c) * 2), 0, 16); }
    asm volatile("s_waitcnt lgkmcnt(0)" ::: "memory");
}
template <bool A_BF16, class Epi> __device__ __forceinline__ void meta_tiles(int first, int ntiles, const void* A, int lda, const float* gain, const bf16* Bt, int K, LAS float* scr, int lane, int wave, const Epi& epi) {
    const int r = lane & 15, q = lane >> 4, kc = K / 8;
    for (int tile = first; tile < ntiles; tile += 256) { const int n0 = tile * 16; f32x4 acc = {0.f, 0.f, 0.f, 0.f}; float ss = 0.f;
#pragma unroll 4
        for (int k0 = wave * kc; k0 < wave * kc + kc; k0 += 32) { const int kk = k0 + 8 * q; bf16x8 a;
            if constexpr (A_BF16) a = *(const bf16x8*)((const bf16*)A + (size_t)r * lda + kk);
            else { f32x4 x0 = *(const f32x4*)((const float*)A + (size_t)r * lda + kk), x1 = *(const f32x4*)((const float*)A + (size_t)r * lda + kk + 4);
                ss += (x0[0] * x0[0] + x0[1] * x0[1]) + (x0[2] * x0[2] + x0[3] * x0[3]) + (x1[0] * x1[0] + x1[1] * x1[1]) + (x1[2] * x1[2] + x1[3] * x1[3]);
                if (gain) { x0 = x0 * *(const f32x4*)(gain + kk); x1 = x1 * *(const f32x4*)(gain + kk + 4); }
                v4u w; w.x = pk2(x0[0], x0[1]); w.y = pk2(x0[2], x0[3]); w.z = pk2(x1[0], x1[1]); w.w = pk2(x1[2], x1[3]); a = __builtin_bit_cast(bf16x8, w); }
            const bf16x8 b = *(const bf16x8*)(Bt + (size_t)(n0 + r) * K + kk);
            acc = __builtin_amdgcn_mfma_f32_16x16x32_bf16(a, b, acc, 0, 0, 0); }
        ss += __shfl_xor(ss, 16); ss += __shfl_xor(ss, 32);
        LAS float* p = scr + (wave * 64 + lane) * 5; p[0] = acc[0]; p[1] = acc[1]; p[2] = acc[2]; p[3] = acc[3]; p[4] = ss;
        __syncthreads();
        if (wave == 0) { f32x4 t = {0.f, 0.f, 0.f, 0.f}; float st = 0.f;
#pragma unroll
            for (int w = 0; w < 8; ++w) { const LAS float* pw = scr + (w * 64 + lane) * 5; t[0] += pw[0]; t[1] += pw[1]; t[2] += pw[2]; t[3] += pw[3]; st += pw[4]; }
            epi(t, st, n0); }
        __syncthreads(); }
}

#ifndef REP_SYNC
#define REP_SYNC 1
#endif
#ifndef REP_P0
#define REP_P0 1
#endif
#ifndef REP_P1
#define REP_P1 1
#endif
#ifndef REP_P2
#define REP_P2 1
#endif
#ifndef REP_P2H
#define REP_P2H 1
#endif
#ifndef REP_P3
#define REP_P3 1
#endif
#ifndef REP_P4
#define REP_P4 1
#endif
#ifndef REP_P4H
#define REP_P4H 1
#endif
#ifndef REP_P5
#define REP_P5 1
#endif
#define GRID_SYNC() do { _Pragma("unroll 1") for (int rs_ = 0; rs_ < REP_SYNC; ++rs_) { XcdBarrier b_; b_.bar = (unsigned*)(args.ws + WS_BAR); b_.x = xb_xcc_id(); b_.st = (volatile LAS unsigned*)((LAS unsigned char*)lds + MISC_OFF) + 8; xcd_barrier(b_); } } while (0)
#define PHASE_IDS() unsigned char* ws = args.ws; int tid = threadIdx.x; asm volatile("" : "+v"(tid)); const int lane = tid & 63, wave = __builtin_amdgcn_readfirstlane(tid >> 6); \
    int bx = blockIdx.x; asm volatile("" : "+s"(bx)); const int G = 256, vcu = (bx % 8) * (G / 8) + bx / 8, gw = vcu * NWAVES + wave, NGW = G * NWAVES; (void)lane; (void)gw; (void)NGW; (void)ws
__global__ void __launch_bounds__(NWAVES * 64, 2) hymba_fwd(Args args) {
    extern __shared__ __attribute__((aligned(16))) unsigned char lds[];
    cg::grid_group grid = cg::this_grid();
    LAS unsigned char* ldsl = (LAS unsigned char*)lds;
    {
        if (threadIdx.x < 32) ((volatile LAS unsigned*)(ldsl + MISC_OFF))[threadIdx.x] = 0u;
        __syncthreads();
        (void)xcd_barrier_post((unsigned*)(args.ws + WS_BAR), (volatile LAS unsigned*)(ldsl + MISC_OFF) + 8);
        if (args.out == nullptr) grid.sync();
    }

#pragma unroll 1
    for (int rep_ = 0; rep_ < REP_P0; ++rep_) {
        PHASE_IDS();
        bf16* Win_t = (bf16*)(ws + WS_WIN); bf16* Wo_t = (bf16*)(ws + WS_WO); bf16* Wup_t = (bf16*)(ws + WS_WUP); bf16* Wdn_t = (bf16*)(ws + WS_WDN); float* BPART = (float*)(ws + WS_BPART); bf16* XN = (bf16*)(ws + WS_XN); const float* x = args.in[I_X];
        LAS float* scr = (LAS float*)(ldsl + RING_OFF + wave * 16384);
        constexpr int I_IN = (D / 64) * (NIN / 32), I_O = (512 / 64) * (D / 32), I_UP = (D / 64) * (NUP / 32), I_DN = 0;
        constexpr int I_FOLD = 4 * 16 * 16, I_BP = 16 * 16, NITEMS = I_FOLD + I_IN + I_O + I_UP + I_DN + I_BP;
        const float* gm = args.in[I_GMIX];
        for (int m = gw; m < MR; m += 2 * NGW) {
            const f32x4* xa = (const f32x4*)(x + (size_t)m * D) + lane; const f32x4* xb = (const f32x4*)(x + (size_t)(m + NGW) * D) + lane; f32x4 va[4], vb[4]; float sa = 0.f, sb = 0.f;
#pragma unroll
            for (int j = 0; j < 4; ++j) { va[j] = __builtin_nontemporal_load(xa + 64 * j); vb[j] = __builtin_nontemporal_load(xb + 64 * j); }
#pragma unroll
            for (int j = 0; j < 4; ++j) { sa += (va[j].x * va[j].x + va[j].y * va[j].y) + (va[j].z * va[j].z + va[j].w * va[j].w); sb += (vb[j].x * vb[j].x + vb[j].y * vb[j].y) + (vb[j].z * vb[j].z + vb[j].w * vb[j].w); }
#pragma unroll
            for (int o = 1; o < 64; o <<= 1) { sa += __shfl_xor(sa, o); sb += __shfl_xor(sb, o); }
            const float ra = 1.0f / sqrtf(sa * (1.0f / D) + EPS), rb = 1.0f / sqrtf(sb * (1.0f / D) + EPS);
            unsigned long long* oa = (unsigned long long*)(XN + (size_t)m * D) + lane; unsigned long long* ob = (unsigned long long*)(XN + (size_t)(m + NGW) * D) + lane;
#pragma unroll
            for (int j = 0; j < 4; ++j) { const f32x4 gg = ((const f32x4*)gm)[lane + 64 * j]; const f32x4 ya = va[j] * ra * gg, yb = vb[j] * rb * gg;
                oa[64 * j] = (unsigned long long)pk2(ya.x, ya.y) | ((unsigned long long)pk2(ya.z, ya.w) << 32); ob[64 * j] = (unsigned long long)pk2(yb.x, yb.y) | ((unsigned long long)pk2(yb.z, yb.w) << 32); }
        }
            for (int c = bx * (NWAVES * 64) + tid; c < 2 * 2 * (KPAD - NMETA) * 64; c += G * NWAVES * 64) {
            const int ch = c & 63, row = (c >> 6) % (KPAD - NMETA), bb = ((c >> 6) / (KPAD - NMETA)) & 1, which = (c >> 6) / (2 * (KPAD - NMETA));
            *(v4u*)((bf16*)(ws + (which ? WS_V : WS_K)) + (size_t)(bb * TP + row) * 512 + ch * 8) = (v4u){0u, 0u, 0u, 0u}; }
        for (int it = wave * G + vcu; it < NITEMS; it += NGW) {
            int r = it;
            if (r < I_FOLD) {
                const int g = r >> 8, cc = (r >> 4) & 15, nb = r & 15, n = nb * 64 + lane, c0 = cc * 8;
                const float* Wp = args.in[I_WPOOL] + (size_t)(g * 128 + c0) * 128; const float* ps = args.in[I_PSCALE] + g * 128; const float* Wo = args.in[I_WOUT] + (size_t)(g * 128) * D + n;
                float a8[8] = {0.f, 0.f, 0.f, 0.f, 0.f, 0.f, 0.f, 0.f};
#pragma unroll 32
                for (int d = 0; d < 128; ++d) { const float w = Wo[(size_t)d * D] * ps[d];
#pragma unroll
                    for (int i = 0; i < 8; ++i) a8[i] += Wp[i * 128 + d] * w; }
                v4u o; o.x = pk2(a8[0], a8[1]); o.y = pk2(a8[2], a8[3]); o.z = pk2(a8[4], a8[5]); o.w = pk2(a8[6], a8[7]);
                *(v4u*)(Wo_t + (size_t)n * D + g * 128 + c0) = o; continue; }
            r -= I_FOLD;
            if (r < I_IN) { const int nblk = NIN / 32, kb = r / nblk, nb = r % nblk, n0 = 32 * nb;
                const int drow = (n0 >= 512 && n0 < 1536) ? (n0 & ~255) + 128 * ((n0 >> 5) & 1) + 32 * ((n0 & 255) >> 6) : n0;
                transpose_item(args.in[I_WIN], NIN, 64 * kb, n0, Win_t, D, drow, 64 * kb, scr, lane); continue; }
            r -= I_IN;
            if (r < I_O) { const int nblk = D / 32, kb = r / nblk, nb = r % nblk; transpose_item(args.in[I_WOUT], D, 512 + 64 * kb, 32 * nb, Wo_t, D, 32 * nb, 512 + 64 * kb, scr, lane); continue; }
            r -= I_O;
            if (r < I_UP) { const int nblk = NUP / 32, kb = r / nblk, nb = r % nblk, n0 = 32 * nb; const int j = n0 < DFF ? n0 : n0 - DFF; const int drow = (j >> 7) * 256 + (j & 127) + (n0 < DFF ? 0 : 128);
                transpose_item(args.in[I_WUP], NUP, 64 * kb, n0, Wup_t, D, drow, 64 * kb, scr, lane, args.in[I_GFFN]); continue; }
            r -= I_UP;
            {
                const int kc = r >> 4, nb = r & 15, n = nb * 64 + lane; float a = 0.f;
#pragma unroll
                for (int k = kc * 32; k < kc * 32 + 32; ++k) a += args.in[I_BPOOL][k] * args.in[I_PSCALE][k] * args.in[I_WOUT][(size_t)k * D + n];
                BPART[kc * D + n] = a; }
        }
}
    GRID_SYNC();

#pragma unroll 1
    for (int rep_ = 0; rep_ < REP_P1; ++rep_) {
        PHASE_IDS();
        bf16* Win_t = (bf16*)(ws + WS_WIN); bf16* XN = (bf16*)(ws + WS_XN); bf16* UB = (bf16*)(ws + WS_U); const float* meta = args.in[I_META];
        if (bx == 255) { const float* BPART = (const float*)(ws + WS_BPART); float* BEFF = (float*)(ws + WS_BEFF);
            for (int n = tid; n < D; n += NWAVES * 64) { float a = 0.f;
#pragma unroll
                for (int kc = 0; kc < 16; ++kc) a += BPART[kc * D + n]; BEFF[n] = a; } }
        if (bx < NIN / 64) {
            LAS float* scr = (LAS float*)(ldsl + RING_OFF);
            const int grp = bx, tsec = grp >> 3, j = wave >> 1, r = lane & 15, q = lane >> 4;
            const bool qk = (tsec == 1 || tsec == 2);
            const int brow = qk ? ((grp * 64) & ~255) + 32 * (grp & 3) + (j & 1) * 16 + (j >> 1) * 128 : grp * 64 + 16 * j;
            f32x4 acc = {0.f, 0.f, 0.f, 0.f}; float ss = 0.f; const float* gain = args.in[I_GMIX];
#pragma unroll 4
            for (int k0 = (wave & 1) * 512; k0 < (wave & 1) * 512 + 512; k0 += 32) { const int kk = k0 + 8 * q;
                f32x4 x0 = *(const f32x4*)(meta + (size_t)r * D + kk), x1 = *(const f32x4*)(meta + (size_t)r * D + kk + 4);
                ss += (x0[0] * x0[0] + x0[1] * x0[1]) + (x0[2] * x0[2] + x0[3] * x0[3]) + (x1[0] * x1[0] + x1[1] * x1[1]) + (x1[2] * x1[2] + x1[3] * x1[3]);
                x0 = x0 * *(const f32x4*)(gain + kk); x1 = x1 * *(const f32x4*)(gain + kk + 4);
                v4u w; w.x = pk2(x0[0], x0[1]); w.y = pk2(x0[2], x0[3]); w.z = pk2(x1[0], x1[1]); w.w = pk2(x1[2], x1[3]);
                const bf16x8 b = *(const bf16x8*)(Win_t + (size_t)(brow + r) * D + kk);
                acc = __builtin_amdgcn_mfma_f32_16x16x32_bf16(__builtin_bit_cast(bf16x8, w), b, acc, 0, 0, 0); }
            ss += __shfl_xor(ss, 16); ss += __shfl_xor(ss, 32);
            { LAS float* p = scr + (wave * 64 + lane) * 5; p[0] = acc[0]; p[1] = acc[1]; p[2] = acc[2]; p[3] = acc[3]; p[4] = ss; }
            __syncthreads();
            if (wave == 0) {
                const float rstd = 1.0f / sqrtf((scr[lane * 5 + 4] + scr[(64 + lane) * 5 + 4]) * (1.0f / D) + EPS);
                float rsr[4];
#pragma unroll
                for (int jj = 0; jj < 4; ++jj) rsr[jj] = __shfl(rstd, 4 * q + jj);
                float val[4][4], s2[4] = {0.f, 0.f, 0.f, 0.f};
#pragma unroll
                for (int tj = 0; tj < 4; ++tj)
#pragma unroll
                    for (int jj = 0; jj < 4; ++jj) { const float v = (scr[((2 * tj) * 64 + lane) * 5 + jj] + scr[((2 * tj + 1) * 64 + lane) * 5 + jj]) * rsr[jj]; val[tj][jj] = v; s2[jj] += v * v; }
                const float* gp = (tsec == 1) ? args.in[I_QG] : args.in[I_KG]; const float sc = (tsec == 1) ? attn_body::C2 : 1.0f;
                bf16* base = (bf16*)(ws + WS_U + (size_t)tsec * SPLIT_STRIDE_B);
#pragma unroll
                for (int jj = 0; jj < 4; ++jj) { float rn = 1.0f;
                    if (qk) { float t2 = s2[jj]; t2 += __shfl_xor(t2, 1); t2 += __shfl_xor(t2, 2); t2 += __shfl_xor(t2, 4); t2 += __shfl_xor(t2, 8); rn = sc / sqrtf(t2 * (1.0f / 64.0f) + EPS); }
                    const int row = 4 * q + jj;
#pragma unroll
                    for (int tj = 0; tj < 4; ++tj) { const int c64 = 16 * tj + r, cc = (grp & 7) * 64 + c64; const bf16 v = (bf16)f2bf(val[tj][jj] * rn * (qk ? gp[c64] : 1.0f));
                        if (tsec < 2) base[(size_t)(MR + row) * 512 + cc] = v; else { base[(size_t)(KPAD - NMETA + row) * 512 + cc] = v; base[(size_t)(TP + KPAD - NMETA + row) * 512 + cc] = v; } } }
            }
            __syncthreads();
        }
        pg8::Gemm g{XN, Win_t, MR, NIN, D}; pg8::StaticOrder S; S.init(MR, NIN, G, bx);
        pg8::EpiQKV E{UB, SPLIT_STRIDE_B / 2, KPAD, args.in[I_QG], args.in[I_KG], attn_body::C2};
        pg8::gemm_phase<pg8::EpiQKV, pg8::StaticOrder, PG8_ALIGN, PG8_SP2>(ldsl + RING_OFF, g, S, E);
    }
    GRID_SYNC();


#pragma unroll 1
    for (int rep_ = 0; rep_ < REP_P2; ++rep_) {
        PHASE_IDS();
        bf16* QB_ = (bf16*)(ws + WS_Q); bf16* KB = (bf16*)(ws + WS_K); bf16* VB = (bf16*)(ws + WS_V); bf16* OB = (bf16*)(ws + WS_O); float* LSE = (float*)(ws + WS_LSE);
        const attn_body::AttnTensors AT{(const attn_body::bf16*)QB_, (const attn_body::bf16*)KB, (const attn_body::bf16*)VB, (attn_body::bf16*)OB};
        const attn_body::StaticOrder S(G, bx);
        attn_body::attn_phase<attn_body::StaticOrder>((char*)lds + RING_OFF, AT, S);
    }
    GRID_SYNC();

#pragma unroll 1
    for (int rep_ = 0; rep_ < REP_P2H; ++rep_) {
        PHASE_IDS();
        bf16* UB = (bf16*)(ws + WS_U); bf16* QB_ = (bf16*)(ws + WS_Q); bf16* KB = (bf16*)(ws + WS_K); bf16* VB = (bf16*)(ws + WS_V); bf16* OB = (bf16*)(ws + WS_O); float* LSE = (float*)(ws + WS_LSE); bf16* MIX = (bf16*)(ws + WS_MIX);
        LAS float* Km = (LAS float*)(ldsl); LAS float* Vm = Km + 16 * 516;
        for (int c = tid; c < 2 * 16 * 64; c += NWAVES * 64) { const int which = c >> 10, j = (c >> 6) & 15, ch = c & 63;
            const v4u w = *(const v4u*)((which ? VB : KB) + (size_t)(KPAD - NMETA + j) * 512 + ch * 8); float f[8]; unpack8(w, f);
            LAS float* d = (which ? Vm : Km) + j * 516 + ch * 8; *(LAS f32x4*)d = (f32x4){f[0], f[1], f[2], f[3]}; *(LAS f32x4*)(d + 4) = (f32x4){f[4], f[5], f[6], f[7]}; }
        __syncthreads();
        float lam;
        { const float a = wave_sum(args.in[I_LQ1][lane] * args.in[I_LK1][lane]), b = wave_sum(args.in[I_LQ2][lane] * args.in[I_LK2][lane]); lam = expf(a) - expf(b) + LAM_INIT; }
        const int h = lane >> 4, i = lane & 15;
        float sg[8];
#pragma unroll
        for (int e = 0; e < 8; ++e) sg[e] = args.in[I_SUBG][8 * i + e] * (1.0f - LAM_INIT);
        const __amdgpu_buffer_rsrc_t mixr = __builtin_amdgcn_make_buffer_rsrc(MIX, 0, (int)((unsigned)MA * D * 2u), 0x00020000);
        auto finish_row = [&](int R, float (&o8)[8]) {
            float ss = 0.f;
#pragma unroll
            for (int e = 0; e < 8; ++e) ss += o8[e] * o8[e];
            ss += __shfl_xor(ss, 1); ss += __shfl_xor(ss, 2); ss += __shfl_xor(ss, 4); ss += __shfl_xor(ss, 8);
            const float rs = 1.0f / sqrtf(ss * (1.0f / 128.0f) + EPS);
#pragma unroll
            for (int e = 0; e < 8; ++e) o8[e] *= rs * sg[e];
            v4u o; o.x = pk2(o8[0], o8[1]); o.y = pk2(o8[2], o8[3]); o.z = pk2(o8[4], o8[5]); o.w = pk2(o8[6], o8[7]); __builtin_amdgcn_raw_buffer_store_b128(o, mixr, (unsigned)((R * D + 512 + h * 128 + 8 * i) * 2), 0, 16);
        };
        const int ch = h * 128 + 8 * i, w = 2 << h;
        {
            const int R0 = 8 * gw, b = R0 >> 13, pos0 = (R0 & (T - 1)) + NMETA; float sum[8] = {0.f, 0.f, 0.f, 0.f, 0.f, 0.f, 0.f, 0.f};
            auto urow = [&](int pp) { return UB + (size_t)(pp >= NMETA ? b * T + pp - NMETA : MR + pp) * 512 + ch; };
#pragma unroll 4
            for (int kk = 1; kk < 16; ++kk) { if (kk < w) { const v4u wv = *(const v4u*)urow(pos0 - kk); float f[8]; unpack8(wv, f);
#pragma unroll
                    for (int e = 0; e < 8; ++e) sum[e] += f[e]; } }
            const float invw = 1.0f / (float)w;
#pragma unroll 1
            for (int r0 = 0; r0 < 8; r0 += 4) {
                v4u wcv[4], wov[4], o0v[4], o1v[4];
#pragma unroll
                for (int k = 0; k < 4; ++k) { const int R = R0 + r0 + k, pos = pos0 + r0 + k;
                    wcv[k] = *(const v4u*)urow(pos); wov[k] = *(const v4u*)urow(pos - w);
                    o0v[k] = *(const v4u*)(OB + (size_t)R * 1024 + h * 256 + 8 * i); o1v[k] = *(const v4u*)(OB + (size_t)R * 1024 + h * 256 + 128 + 8 * i); }
                asm volatile("" ::: "memory");
#pragma unroll
                for (int k = 0; k < 4; ++k) { const int R = R0 + r0 + k;
                    float cur[8], old[8]; unpack8(wcv[k], cur); unpack8(wov[k], old); float pl[8];
#pragma unroll
                    for (int e = 0; e < 8; ++e) { if (r0 + k > 0) sum[e] -= old[e]; sum[e] += cur[e]; pl[e] = sum[e] * invw - cur[e]; }
                    v4u o; o.x = pk2(pl[0], pl[1]); o.y = pk2(pl[2], pl[3]); o.z = pk2(pl[4], pl[5]); o.w = pk2(pl[6], pl[7]); __builtin_amdgcn_raw_buffer_store_b128(o, mixr, (unsigned)((R * D + ch) * 2), 0, 16);
                    float a0[8], a1[8], o8[8]; unpack8(o0v[k], a0); unpack8(o1v[k], a1);
#pragma unroll
                    for (int e = 0; e < 8; ++e) o8[e] = a0[e] - lam * a1[e];
                    finish_row(R, o8); }
                asm volatile("" ::: "memory"); }
        }
        if (gw < NMETA) {
            const int pos = gw, R = MR + pos, cnt = (pos + 1) < w ? (pos + 1) : w; float sum[8] = {0.f, 0.f, 0.f, 0.f, 0.f, 0.f, 0.f, 0.f}, cur[8] = {0.f, 0.f, 0.f, 0.f, 0.f, 0.f, 0.f, 0.f};
            for (int kk = 0; kk < 16; ++kk) { if (kk < cnt) { const v4u wv = *(const v4u*)(UB + (size_t)(MR + pos - kk) * 512 + ch); float f[8]; unpack8(wv, f);
#pragma unroll
                    for (int e = 0; e < 8; ++e) { sum[e] += f[e]; if (kk == 0) cur[e] = f[e]; } } }
            const float inv = 1.0f / (float)cnt; float pl[8];
#pragma unroll
            for (int e = 0; e < 8; ++e) pl[e] = sum[e] * inv - cur[e];
            v4u o; o.x = pk2(pl[0], pl[1]); o.y = pk2(pl[2], pl[3]); o.z = pk2(pl[4], pl[5]); o.w = pk2(pl[6], pl[7]); *(v4u*)(MIX + (size_t)R * D + ch) = o;
            float o8[8] = {0.f, 0.f, 0.f, 0.f, 0.f, 0.f, 0.f, 0.f};
            const bool b3 = (i & 8) != 0, b2 = (i & 4) != 0, b1 = (i & 2) != 0, b0 = (i & 1) != 0;
#pragma unroll 1
            for (int c = 0; c < 2; ++c) {
                const unsigned long long qw = *(const unsigned long long*)(QB_ + (size_t)R * 512 + h * 128 + c * 64 + 4 * i);
                const float q0 = bflo((unsigned)qw), q1 = bfhi((unsigned)qw), q2 = bflo((unsigned)(qw >> 32)), q3 = bfhi((unsigned)(qw >> 32));
                const LAS float* kp = Km + h * 128 + c * 64 + 4 * i; float part[16];
#pragma unroll
                for (int j = 0; j < 16; ++j) { const f32x4 k = *(const LAS f32x4*)(kp + j * 516); part[j] = (q0 * k[0] + q1 * k[1]) + (q2 * k[2] + q3 * k[3]); }
#pragma unroll
                for (int j = 0; j < 8; ++j) { const float keep = b3 ? part[j + 8] : part[j], send = b3 ? part[j] : part[j + 8]; part[j] = keep + __shfl_xor(send, 8); }
#pragma unroll
                for (int j = 0; j < 4; ++j) { const float keep = b2 ? part[j + 4] : part[j], send = b2 ? part[j] : part[j + 4]; part[j] = keep + __shfl_xor(send, 4); }
#pragma unroll
                for (int j = 0; j < 2; ++j) { const float keep = b1 ? part[j + 2] : part[j], send = b1 ? part[j] : part[j + 2]; part[j] = keep + __shfl_xor(send, 2); }
                float sc; { const float keep = b0 ? part[1] : part[0], send = b0 ? part[0] : part[1]; sc = keep + __shfl_xor(send, 1); }
                if (i > pos) sc = -INFINITY;
                float m = sc; m = fmaxf(m, __shfl_xor(m, 1)); m = fmaxf(m, __shfl_xor(m, 2)); m = fmaxf(m, __shfl_xor(m, 4)); m = fmaxf(m, __shfl_xor(m, 8));
                const float p = exp2f(sc - m); float l = p; l += __shfl_xor(l, 1); l += __shfl_xor(l, 2); l += __shfl_xor(l, 4); l += __shfl_xor(l, 8);
                float om[8] = {0.f, 0.f, 0.f, 0.f, 0.f, 0.f, 0.f, 0.f};
#pragma unroll 4
                for (int j = 0; j < 16; ++j) { const float pj = __shfl(p, (lane & 48) + j); const LAS float* vp = Vm + j * 516 + h * 128 + 8 * i; const f32x4 v0 = *(const LAS f32x4*)vp, v1 = *(const LAS f32x4*)(vp + 4);
                    om[0] += pj * v0[0]; om[1] += pj * v0[1]; om[2] += pj * v0[2]; om[3] += pj * v0[3]; om[4] += pj * v1[0]; om[5] += pj * v1[1]; om[6] += pj * v1[2]; om[7] += pj * v1[3]; }
                const float coef = ((c == 0) ? 1.0f : -lam) / l;
#pragma unroll
                for (int e = 0; e < 8; ++e) o8[e] += om[e] * coef;
            }
            finish_row(R, o8);
        }
    }
    GRID_SYNC();

#pragma unroll 1
    for (int rep_ = 0; rep_ < REP_P3; ++rep_) {
        PHASE_IDS();
        bf16* Wo_t = (bf16*)(ws + WS_WO); float* BEFF = (float*)(ws + WS_BEFF); float* H1M = (float*)(ws + WS_H1M); float* SSQ = (float*)(ws + WS_SSQ); bf16* XN = (bf16*)(ws + WS_XN); bf16* MIX = (bf16*)(ws + WS_MIX); const float* x = args.in[I_X]; const float* meta = args.in[I_META]; float* out = args.out;
        meta_tiles<true>(bx, D / 16, MIX + (size_t)MR * D, D, nullptr, Wo_t, D, (LAS float*)(ldsl + RING_OFF), lane, wave, [&](const f32x4& acc, float ss, int n0) { (void)ss;
            const int col = n0 + (lane & 15);
#pragma unroll
            for (int j = 0; j < 4; ++j) { const int row = 4 * (lane >> 4) + j; H1M[row * D + col] = meta[row * D + col] + acc[j] + BEFF[col]; } });
        pg8::Gemm g{MIX, Wo_t, MR, D, D}; pg8::StaticOrder S; S.init(MR, D, G, bx);
        pg8::EpiWo E{x, XN, BEFF, SSQ};
        pg8::gemm_phase<pg8::EpiWo, pg8::StaticOrder, false, PG8_SP2>(ldsl + RING_OFF, g, S, E);
    }
    GRID_SYNC();

#pragma unroll 1
    for (int rep_ = 0; rep_ < REP_P4; ++rep_) {
        PHASE_IDS();
        bf16* Wup_t = (bf16*)(ws + WS_WUP); float* H1M = (float*)(ws + WS_H1M); float* UM = (float*)(ws + WS_UM); float* SSQ = (float*)(ws + WS_SSQ); float* HRAW = (float*)(ws + WS_HRAW); bf16* XN = (bf16*)(ws + WS_XN); bf16* ACT = (bf16*)(ws + WS_ACT);
        meta_tiles<false>(255 - bx, NUP / 16, H1M, D, nullptr, Wup_t, D, (LAS float*)(ldsl + RING_OFF), lane, wave, [&](const f32x4& acc, float ss, int n0) {
            const float rstd = 1.0f / sqrtf(ss * (1.0f / D) + EPS); const int col = n0 + (lane & 15);
#pragma unroll
            for (int j = 0; j < 4; ++j) { const int row = 4 * (lane >> 4) + j; const float rsr = __shfl(rstd, row); UM[row * NUP + col] = acc[j] * rsr; } });
        pg8::Gemm g{XN, Wup_t, MR, NUP, D}; pg8::StaticOrder S; S.init(MR, NUP, G, bx);
        pg8::EpiUp E{SSQ, args.in[I_CONVW], args.in[I_CONVB], ACT, HRAW};
        pg8::gemm_phase<pg8::EpiUp, pg8::StaticOrder, PG8_ALIGN, PG8_SP2>(ldsl + RING_OFF, g, S, E);
        if (bx >= 128) {
            bf16* Wdn_t = (bf16*)(ws + WS_WDN); LAS float* scr = (LAS float*)(ldsl + RING_OFF + wave * 16384);
            for (int r = (bx - 128) * NWAVES + wave; r < (DFF / 64) * (D / 32); r += 128 * NWAVES) { const int nblk = D / 32, kb = r / nblk, nb = r % nblk;
                transpose_item(args.in[I_WDOWN], D, 64 * kb, 32 * nb, Wdn_t, DFF, 32 * nb, 64 * kb, scr, lane); }
        }
    }
    GRID_SYNC();

#pragma unroll 1
    for (int rep_ = 0; rep_ < REP_P4H; ++rep_) {
        PHASE_IDS();
        float* UM = (float*)(ws + WS_UM); float* HRAW = (float*)(ws + WS_HRAW); bf16* ACT = (bf16*)(ws + WS_ACT);
        const float* cw = args.in[I_CONVW]; const float* cb = args.in[I_CONVB];
        for (int idx = bx * (NWAVES * 64) + tid; idx < 256 * DFF; idx += G * NWAVES * 64) {
            const int blk = idx / DFF, j = idx - blk * DFF, ng = (j >> 7) * 256 + (j & 127);
            const float* h0 = HRAW + (size_t)blk * 4 * NUP; const float* pm2 = (blk & 127) ? HRAW + (size_t)(blk - 1) * 4 * NUP : UM + 14 * NUP; const float* pm1 = pm2 + NUP;
            float c0[2], c1[2];
#pragma unroll
            for (int gv = 0; gv < 2; ++gv) { const int np = ng + gv * 128, cc = j + gv * DFF; const float u_2 = pm2[np], u_1 = pm1[np], u0 = h0[2 * NUP + np], u1 = h0[3 * NUP + np];
                const float w0 = cw[cc], w1 = cw[NUP + cc], w2 = cw[2 * NUP + cc], bb = cb[cc];
                c0[gv] = w0 * u_2 + w1 * u_1 + w2 * u0 + bb; c1[gv] = w0 * u_1 + w1 * u0 + w2 * u1 + bb; }
            ACT[(size_t)(64 * blk) * DFF + j] = (bf16)f2bf(pg8::silu_mul(c0[0], c0[1])); ACT[(size_t)(64 * blk + 1) * DFF + j] = (bf16)f2bf(pg8::silu_mul(c1[0], c1[1]));
        }
    }
    GRID_SYNC();

#pragma unroll 1
    for (int rep_ = 0; rep_ < REP_P5; ++rep_) {
        PHASE_IDS();
        bf16* Wdn_t = (bf16*)(ws + WS_WDN); bf16* ACT = (bf16*)(ws + WS_ACT); float* out = args.out;
        pg8::Gemm g{ACT, Wdn_t, MR, D, DFF}; pg8::StaticOrder S; S.init(MR, D, G, bx);
        pg8::EpiDown E{(const bf16*)(ws + WS_XN), out};
        pg8::gemm_phase<pg8::EpiDown, pg8::StaticOrder, PG8_ALIGN, PG8_SP2>(ldsl + RING_OFF, g, S, E);
    }
}

extern "C" void kernel_launch(void* const* d_in, const int* in_sizes, int n_in, void* d_out, int out_size, void* d_ws, size_t ws_size, hipStream_t stream) {
    static int grid = 0;
    if (grid == 0) {
        if (n_in != 20 || in_sizes[0] != MR * D || out_size != MR * D || ws_size < WS_END) { fprintf(stderr, "kernel_launch: unexpected shapes (n_in %d, in0 %d, out %d, ws %zu)\n", n_in, n_in > 0 ? in_sizes[0] : -1, out_size, ws_size); grid = -1; return; }
        if (hipFuncSetAttribute((const void*)hymba_fwd, hipFuncAttributeMaxDynamicSharedMemorySize, LDS_BYTES) != hipSuccess) { fprintf(stderr, "kernel_launch: hipFuncSetAttribute failed\n"); grid = -1; return; }
        int dev = 0, cus = 0, per_cu = 0;
        (void)hipGetDevice(&dev); (void)hipDeviceGetAttribute(&cus, hipDeviceAttributeMultiprocessorCount, dev);
        (void)hipOccupancyMaxActiveBlocksPerMultiprocessor(&per_cu, (const void*)hymba_fwd, NWAVES * 64, LDS_BYTES);
        (void)hipGetLastError();
        if (cus < 256 || per_cu < 1) fprintf(stderr, "kernel_launch: note: %d CUs, %d blocks per CU reported; this kernel needs 256 co-resident workgroups\n", cus, per_cu);
        grid = 256;
    }
    if (grid < 0) return;
    if (hipMemsetAsync((char*)d_ws + WS_BAR, 0, XCD_BAR_WORDS * 4, stream) != hipSuccess) { fprintf(stderr, "kernel_launch: hipMemsetAsync failed\n"); return; }
    Args a{};
    for (int i = 0; i < 20; ++i) a.in[i] = (const float*)d_in[i];
    a.out = (float*)d_out; a.ws = (unsigned char*)d_ws;
    void* kargs[] = {&a};
    const hipError_t le = hipLaunchCooperativeKernel((const void*)hymba_fwd, dim3(grid), dim3(NWAVES * 64), kargs, LDS_BYTES, stream);
    if (le != hipSuccess) fprintf(stderr, "kernel_launch: cooperative launch failed: %s\n", hipGetErrorName(le));
}
```

```cpp
#include <hip/hip_runtime.h>
#include <cstdio>
#include <cstdint>
namespace pg8 {
#define PG8_LAS __attribute__((address_space(3)))
typedef unsigned short bf16_t;
typedef short bf16x8 __attribute__((ext_vector_type(8)));
typedef float f32x4 __attribute__((ext_vector_type(4)));
typedef unsigned u32x4 __attribute__((ext_vector_type(4)));
constexpr int BM = 256, BK = 64, HALF = 128, HTB = HALF * BK * 2  , STAGE_BYTES = 8 * HTB, NXCD = 8, WGM = 8;

__host__ __device__ __forceinline__ int lds_byte(int r, int c) { const int st = (r >> 4) * 2 + (c >> 5), rr = r & 15, cc = c & 31, ob = rr * 64 + cc * 2; return st * 1024 + (ob ^ (((ob >> 9) & 1) << 5)); }
__host__ __device__ __forceinline__ void stage_rc(int b, int& R, int& C) { const int st = b / 1024, sb = b % 1024, swz = sb ^ (((sb >> 9) & 1) << 5); R = (st >> 1) * 16 + swz / 64; C = (st & 1) * 32 + (swz % 64) / 2; }
__host__ __device__ __forceinline__ int perm32(int rho) { const int n = rho >> 4, i = rho & 15; return 8 * (i >> 2) + 4 * n + (i & 3); }

struct Unit { int pm, pn; };
struct Gemm { const bf16_t* A; const bf16_t* Bt; int M, N, K; };

struct StaticOrder {
    int nM, nN, nwg, G, c;
    __host__ __device__ void init(int M, int N, int G_, int c_) { nM = M / BM; nN = N / BM; nwg = nM * nN; G = G_; c = c_; }
    __host__ __device__ bool next(int i, Unit& u) const {
        const long L = (long)i * G + c; if (L >= nwg) return false;
        int wgid = (int)L; { const int q = nwg / NXCD, r = nwg % NXCD, xcd = wgid % NXCD, off = wgid / NXCD; wgid = (xcd < r ? xcd * (q + 1) : r * (q + 1) + (xcd - r) * q) + off; }
        const int nig = WGM * nN, gid = wgid / nig, fm = gid * WGM, gsz = (nM - fm) < WGM ? (nM - fm) : WGM;
        u.pm = fm + ((wgid % nig) % gsz); u.pn = (wgid % nig) / gsz; return true;
    }
    __device__ __forceinline__ void a_ready(const Unit&) const {}
    __device__ __forceinline__ void done(const Unit&) const {}
};

__device__ __forceinline__ unsigned cvt_pk_bf16(float lo, float hi) { unsigned r; asm volatile("v_cvt_pk_bf16_f32 %0, %1, %2" : "=v"(r) : "v"(lo), "v"(hi)); return r; }
typedef float f32x2 __attribute__((ext_vector_type(2)));
typedef float f32x2 __attribute__((ext_vector_type(2)));
typedef unsigned u32x2 __attribute__((ext_vector_type(2)));
__device__ __forceinline__ __amdgpu_buffer_rsrc_t wt_rsrc(void* base, unsigned bytes) { return __builtin_amdgcn_make_buffer_rsrc(base, 0, (int)bytes, 0x00020000); }
__device__ __forceinline__ void store16_wt(__amdgpu_buffer_rsrc_t r, unsigned byte_off, u32x4 v) { __builtin_amdgcn_raw_buffer_store_b128(v, r, byte_off, 0, 16); }

struct EpiQKV {
    static constexpr bool PERM = true, AFTER_DRAIN = false;
    bf16_t* O; size_t split_stride; int kv_pad; const float* gq; const float* gk; float qscale;
    __device__ __forceinline__ void operator()(const f32x4 (&acc)[2][2][4][2], const Unit& u, int wr, int wc, int fr, int fq) const {
        const int t = u.pn >> 1, colt = (u.pn & 1) * BM; const __amdgpu_buffer_rsrc_t outr = wt_rsrc(O, (unsigned)(4 * split_stride * 2)); const unsigned tb = (unsigned)(t * split_stride * 2);
        const int row0 = u.pm * BM + wr * 64 + fr + (t >= 2 ? kv_pad * ((u.pm >> 5) + 1) : 0);
        if (t == 1 || t == 2) {
            const float* gp = (t == 1) ? gq : gk; const float sc = (t == 1) ? qscale : 1.0f; f32x4 gv[2][2];
#pragma unroll
            for (int bj = 0; bj < 2; ++bj)
#pragma unroll
                for (int n = 0; n < 2; ++n) gv[bj][n] = *(const f32x4*)(gp + 32 * bj + 8 * fq + 4 * n) * sc;
            const int col0 = colt + 64 * wc + 8 * fq;
#pragma unroll
            for (int ai = 0; ai < 2; ++ai)
#pragma unroll
                for (int m = 0; m < 4; ++m) { float s = 0.f;
#pragma unroll
                    for (int bj = 0; bj < 2; ++bj)
#pragma unroll
                        for (int n = 0; n < 2; ++n) { const f32x4 v = acc[ai][bj][m][n]; s += (v[0] * v[0] + v[1] * v[1]) + (v[2] * v[2] + v[3] * v[3]); }
                    s += __shfl_xor(s, 16); s += __shfl_xor(s, 32);
                    const float rs = __builtin_amdgcn_rsqf(s * (1.0f / 64.0f) + 1e-6f);
                    const unsigned rowb_ = tb + (unsigned)(((row0 + ai * HALF + m * 16) * 512 + col0) * 2);
#pragma unroll
                    for (int bj = 0; bj < 2; ++bj) { const f32x4 v0 = acc[ai][bj][m][0] * rs * gv[bj][0], v1 = acc[ai][bj][m][1] * rs * gv[bj][1];
                        u32x4 w; w.x = cvt_pk_bf16(v0[0], v0[1]); w.y = cvt_pk_bf16(v0[2], v0[3]); w.z = cvt_pk_bf16(v1[0], v1[1]); w.w = cvt_pk_bf16(v1[2], v1[3]);
                        store16_wt(outr, rowb_ + bj * 64, w); } }
        } else {
            const int col0 = colt + wc * 32 + 8 * fq;
#pragma unroll
            for (int ai = 0; ai < 2; ++ai)
#pragma unroll
                for (int m = 0; m < 4; ++m) { const unsigned rowb_ = tb + (unsigned)(((row0 + ai * HALF + m * 16) * 512 + col0) * 2);
#pragma unroll
                    for (int bj = 0; bj < 2; ++bj) { const f32x4 v0 = acc[ai][bj][m][0], v1 = acc[ai][bj][m][1];
                        u32x4 w; w.x = cvt_pk_bf16(v0[0], v0[1]); w.y = cvt_pk_bf16(v0[2], v0[3]); w.z = cvt_pk_bf16(v1[0], v1[1]); w.w = cvt_pk_bf16(v1[2], v1[3]);
                        store16_wt(outr, rowb_ + bj * HALF * 2, w); } }
        }
    }
};
struct EpiWo {
    static constexpr bool PERM = true, AFTER_DRAIN = true;
    const float* __restrict__ x; bf16_t* __restrict__ h1b; const float* __restrict__ bias; float* __restrict__ ssq;
    __device__ __forceinline__ void fused(f32x4 (&acc)[2][2][4][2], const Unit& u, int wr, int wc, int fr, int fq, PG8_LAS unsigned char* lds, int wid, int lane) const {
        PG8_LAS float* P = (PG8_LAS float*)lds;
        const int row0 = u.pm * BM + wr * 64 + fr, col0 = u.pn * BM + wc * 32 + 8 * fq; const __amdgpu_buffer_rsrc_t hr = wt_rsrc(h1b, 16384u * 1024u * 2u);
        f32x4 bv[2][2];
#pragma unroll
        for (int bj = 0; bj < 2; ++bj)
#pragma unroll
            for (int n = 0; n < 2; ++n) bv[bj][n] = *(const f32x4*)(bias + col0 + bj * HALF + n * 4);
#pragma unroll
        for (int ai = 0; ai < 2; ++ai) {
            f32x4 xv[4][2][2];
#pragma unroll
            for (int m = 0; m < 4; ++m)
#pragma unroll
                for (int bj = 0; bj < 2; ++bj)
#pragma unroll
                    for (int n = 0; n < 2; ++n) xv[m][bj][n] = *(const f32x4*)(x + (size_t)(row0 + ai * HALF + m * 16) * 1024 + col0 + bj * HALF + n * 4);
            asm volatile("" ::: "memory");
#pragma unroll
            for (int m = 0; m < 4; ++m) { const int row = row0 + ai * HALF + m * 16; const size_t off = (size_t)row * 1024 + col0; float s = 0.f;
#pragma unroll
                for (int bj = 0; bj < 2; ++bj) { u32x4 w;
#pragma unroll
                    for (int n = 0; n < 2; ++n) { const f32x4 h = xv[m][bj][n] + acc[ai][bj][m][n] + bv[bj][n];
                        s += (h[0] * h[0] + h[1] * h[1]) + (h[2] * h[2] + h[3] * h[3]);
                        if (n == 0) { w.x = cvt_pk_bf16(h[0], h[1]); w.y = cvt_pk_bf16(h[2], h[3]); } else { w.z = cvt_pk_bf16(h[0], h[1]); w.w = cvt_pk_bf16(h[2], h[3]); } }
                    store16_wt(hr, (unsigned)((off + bj * HALF) * 2), w); }
                s += __shfl_xor(s, 16); s += __shfl_xor(s, 32);
                if (fq == 0) P[(ai * HALF + wr * 64 + m * 16 + fr) * 4 + wc] = s; }
        }
        asm volatile("s_waitcnt lgkmcnt(0)" ::: "memory"); __builtin_amdgcn_s_barrier(); asm volatile("" ::: "memory");
        if (lane < 32) { const int r = wid * 32 + lane; const f32x4 p = *(const PG8_LAS f32x4*)(P + r * 4); ssq[(size_t)(u.pm * BM + r) * 4 + u.pn] = (p[0] + p[1]) + (p[2] + p[3]); }
    }
};
struct EpiDown {
    static constexpr bool PERM = true, AFTER_DRAIN = false;
    const bf16_t* __restrict__ h1b; float* __restrict__ out;
    __device__ __forceinline__ void operator()(const f32x4 (&acc)[2][2][4][2], const Unit& u, int wr, int wc, int fr, int fq) const {
        const int row0 = u.pm * BM + wr * 64 + fr, col0 = u.pn * BM + wc * 32 + 8 * fq;
#pragma unroll
        for (int ai = 0; ai < 2; ++ai) {
            u32x4 hv[4][2];
#pragma unroll
            for (int m = 0; m < 4; ++m)
#pragma unroll
                for (int bj = 0; bj < 2; ++bj) hv[m][bj] = *(const u32x4*)(h1b + (size_t)(row0 + ai * HALF + m * 16) * 1024 + col0 + bj * HALF);
            asm volatile("" ::: "memory");
#pragma unroll
            for (int m = 0; m < 4; ++m)
#pragma unroll
                for (int bj = 0; bj < 2; ++bj) { const u32x4 w = hv[m][bj]; float* p = out + (size_t)(row0 + ai * HALF + m * 16) * 1024 + col0 + bj * HALF;
                    f32x4 h0, h1; h0[0] = __builtin_bit_cast(float, w.x << 16); h0[1] = __builtin_bit_cast(float, w.x & 0xffff0000u); h0[2] = __builtin_bit_cast(float, w.y << 16); h0[3] = __builtin_bit_cast(float, w.y & 0xffff0000u);
                    h1[0] = __builtin_bit_cast(float, w.z << 16); h1[1] = __builtin_bit_cast(float, w.z & 0xffff0000u); h1[2] = __builtin_bit_cast(float, w.w << 16); h1[3] = __builtin_bit_cast(float, w.w & 0xffff0000u);
                    *(f32x4*)p = h0 + acc[ai][bj][m][0]; *(f32x4*)(p + 4) = h1 + acc[ai][bj][m][1]; }
        }
    }
};
__device__ __forceinline__ float dpp_prev1(float prevblk, float cur) {
    const int wrap = __builtin_amdgcn_update_dpp(0, __builtin_bit_cast(int, prevblk), 0x121, 0xf, 0xf, true);
    return __builtin_bit_cast(float, __builtin_amdgcn_update_dpp(wrap, __builtin_bit_cast(int, cur), 0x111, 0xf, 0xf, false));
}
__device__ __forceinline__ float dpp_prev2(float prevblk, float cur) {
    const int wrap = __builtin_amdgcn_update_dpp(0, __builtin_bit_cast(int, prevblk), 0x122, 0xf, 0xf, true);
    return __builtin_bit_cast(float, __builtin_amdgcn_update_dpp(wrap, __builtin_bit_cast(int, cur), 0x112, 0xf, 0xf, false));
}
__device__ __forceinline__ float silu_mul(float g, float v) { return g * __builtin_amdgcn_rcpf(1.0f + __builtin_amdgcn_exp2f(-1.4426950408889634f * g)) * v; }
struct EpiUp {
    static constexpr bool PERM = true, AFTER_DRAIN = false;
    const float* ssq; const float* cw; const float* cb; bf16_t* act; float* hraw;
    __device__ __forceinline__ void operator()(const f32x4 (&acc)[2][2][4][2], const Unit& u, int wr, int wc, int fr, int fq) const {
        const int rowb = u.pm * BM + wr * 64 + fr, jl = wc * 32 + 8 * fq, j0 = u.pn * 128 + jl;
        float rs[2][4];
#pragma unroll
        for (int ai = 0; ai < 2; ++ai)
#pragma unroll
            for (int m = 0; m < 4; ++m) { const f32x4 a = *(const f32x4*)(ssq + (size_t)(rowb + ai * HALF + m * 16) * 4);
                rs[ai][m] = __builtin_amdgcn_rsqf(((a[0] + a[1]) + (a[2] + a[3])) * (1.0f / 1024.0f) + 1e-6f); }
        unsigned pk[2][4][2][2]; const __amdgpu_buffer_rsrc_t actr = wt_rsrc(act, 16384u * 2816u * 2u);
#pragma unroll
        for (int n = 0; n < 2; ++n) {
            const int jc = j0 + 4 * n;
            const f32x4 g0 = *(const f32x4*)(cw + jc), g1 = *(const f32x4*)(cw + 5632 + jc), g2 = *(const f32x4*)(cw + 2 * 5632 + jc), gb = *(const f32x4*)(cb + jc);
            const f32x4 v0 = *(const f32x4*)(cw + 2816 + jc), v1 = *(const f32x4*)(cw + 5632 + 2816 + jc), v2 = *(const f32x4*)(cw + 2 * 5632 + 2816 + jc), vb = *(const f32x4*)(cb + 2816 + jc);
#pragma unroll
            for (int ai = 0; ai < 2; ++ai) {
                f32x4 pg = {0.f, 0.f, 0.f, 0.f}, pv = {0.f, 0.f, 0.f, 0.f};
#pragma unroll
                for (int m = 0; m < 4; ++m) {
                    const f32x4 xg = acc[ai][0][m][n] * rs[ai][m], xv = acc[ai][1][m][n] * rs[ai][m];
                    float r[4];
#pragma unroll
                    for (int e = 0; e < 4; ++e) {
                        const float cg = g0[e] * dpp_prev2(pg[e], xg[e]) + g1[e] * dpp_prev1(pg[e], xg[e]) + g2[e] * xg[e] + gb[e];
                        const float cv = v0[e] * dpp_prev2(pv[e], xv[e]) + v1[e] * dpp_prev1(pv[e], xv[e]) + v2[e] * xv[e] + vb[e];
                        r[e] = silu_mul(cg, cv); }
                    pk[ai][m][n][0] = cvt_pk_bf16(r[0], r[1]); pk[ai][m][n][1] = cvt_pk_bf16(r[2], r[3]);
                    if ((m == 0 && fr < 2) || (m == 3 && fr >= 14)) {
                        const int row = rowb + ai * HALF + m * 16; const int slot = (m == 0) ? 2 + fr : fr - 14;
                        float* hp = hraw + ((size_t)(row >> 6) * 4 + slot) * 5632 + u.pn * 256 + jl + 4 * n;
                        *(f32x4*)hp = xg; *(f32x4*)(hp + 128) = xv; }
                    pg = xg; pv = xv; } } }
#pragma unroll
        for (int ai = 0; ai < 2; ++ai)
#pragma unroll
            for (int m = 0; m < 4; ++m) { if (m == 0 && fr < 2) continue;
                u32x4 w; w.x = pk[ai][m][0][0]; w.y = pk[ai][m][0][1]; w.z = pk[ai][m][1][0]; w.w = pk[ai][m][1][1];
                store16_wt(actr, (unsigned)(((rowb + ai * HALF + m * 16) * 2816 + j0) * 2), w); }
    }
};

template <class Epi, class Sched, bool ALIGN_EPI = false, bool SP2 = false>
__device__ __forceinline__ void gemm_phase(PG8_LAS unsigned char* lds, const Gemm g, const Sched& S, const Epi& E) {
    int tid_ = threadIdx.x; asm volatile("" : "+v"(tid_));
    const int tid = tid_, wid = __builtin_amdgcn_readfirstlane(tid >> 6), lane = tid & 63, wr = wid >> 2, wc = wid & 3, fr = lane & 15, fq = lane >> 4;
    const int K = g.K, nt = K / BK;
    unsigned voffA[2], voffB[2];
#pragma unroll
    for (int i = 0; i < 2; ++i) { int R, C; stage_rc(tid * 16 + i * 8192, R, C); const int Rb = Epi::PERM ? ((R & ~31) + perm32(R & 31)) : R;
        voffA[i] = (unsigned)(R * K + C) * 2u; voffB[i] = (unsigned)(Rb * K + C) * 2u; }
    const size_t kstep = (size_t)(BK * 2);
    const size_t hstep = (size_t)HALF * K * 2;
    const size_t tstep = 2 * hstep;
    const unsigned ldsw = (unsigned)wid * 1024u;
    const int aoff = lds_byte(wr * 64 + fr, fq * 8), boff = lds_byte(wc * 32 + fr, fq * 8);
#define PG8_SA(b, h) (((b) * 2 + (h)) * HTB)
#define PG8_SB(b, h) ((4 + (b) * 2 + (h)) * HTB)
#define PG8_STAGE(bufoff, gbase, voff) do { _Pragma("unroll") for (int _i = 0; _i < 2; ++_i) \
        __builtin_amdgcn_global_load_lds((const unsigned*)((const char*)(gbase) + (voff)[_i]), (PG8_LAS unsigned*)(lds + (bufoff) + ldsw + _i * 8192), 16, 0, 0); } while (0)
#define PG8_LDA(dst, b, h) do { _Pragma("unroll") for (int m = 0; m < 4; ++m) _Pragma("unroll") for (int k = 0; k < 2; ++k) dst[m][k] = *(const PG8_LAS bf16x8*)(lds + PG8_SA(b, h) + aoff + m * 2048 + k * 1024); } while (0)
#define PG8_LDB(dst, b, h) do { _Pragma("unroll") for (int n = 0; n < 2; ++n) _Pragma("unroll") for (int k = 0; k < 2; ++k) dst[n][k] = *(const PG8_LAS bf16x8*)(lds + PG8_SB(b, h) + boff + n * 2048 + k * 1024); } while (0)
#define PG8_MMA(ai, bj, At, Bt) do { __builtin_amdgcn_s_setprio(1); _Pragma("unroll") for (int m = 0; m < 4; ++m) _Pragma("unroll") for (int n = 0; n < 2; ++n) _Pragma("unroll") for (int k = 0; k < 2; ++k) \
        acc[ai][bj][m][n] = __builtin_amdgcn_mfma_f32_16x16x32_bf16(Bt[n][k], At[m][k], acc[ai][bj][m][n], 0, 0, 0); __builtin_amdgcn_s_setprio(0); } while (0)
#define PG8_WAIT_V(n) asm volatile("s_waitcnt vmcnt(" #n ")" ::: "memory")
#define PG8_WAIT_L(n) asm volatile("s_waitcnt lgkmcnt(" #n ")" ::: "memory")
#define PG8_BAR __builtin_amdgcn_s_barrier()
#define PG8_SCHED __builtin_amdgcn_sched_barrier(0)
    Unit cur, nxt; int ui = 0;
    if (!S.next(0, cur)) return;
    f32x4 acc[2][2][4][2];
#pragma unroll
    for (int a = 0; a < 2; ++a)
#pragma unroll
        for (int b = 0; b < 2; ++b)
#pragma unroll
            for (int m = 0; m < 4; ++m)
#pragma unroll
                for (int n = 0; n < 2; ++n) acc[a][b][m][n] = (f32x4){0.f, 0.f, 0.f, 0.f};
    bf16x8 At[4][2], B0[2][2], B1[2][2];
    const char* cA = (const char*)g.A + (size_t)cur.pm * tstep; const char* cB = (const char*)g.Bt + (size_t)cur.pn * tstep;
    S.a_ready(cur);
    if constexpr (SP2) {
        PG8_STAGE(PG8_SB(0, 0), cB, voffB); PG8_STAGE(PG8_SB(0, 1), cB + hstep, voffB); PG8_STAGE(PG8_SA(0, 0), cA, voffA); PG8_STAGE(PG8_SA(0, 1), cA + hstep, voffA);
        if (wr == 1) PG8_BAR;
        PG8_WAIT_V(2); PG8_BAR;
        PG8_STAGE(PG8_SB(1, 0), cB + kstep, voffB); PG8_STAGE(PG8_SA(1, 0), cA + kstep, voffA); PG8_STAGE(PG8_SB(1, 1), cB + hstep + kstep, voffB);
        PG8_WAIT_V(6); PG8_BAR;
    } else {
        PG8_STAGE(PG8_SB(0, 0), cB, voffB); PG8_STAGE(PG8_SA(0, 0), cA, voffA); PG8_STAGE(PG8_SB(0, 1), cB + hstep, voffB); PG8_STAGE(PG8_SA(0, 1), cA + hstep, voffA);
        if (wr == 1) PG8_BAR;
        PG8_WAIT_V(4); PG8_BAR;
        PG8_STAGE(PG8_SB(1, 0), cB + kstep, voffB); PG8_STAGE(PG8_SA(1, 0), cA + kstep, voffA); PG8_STAGE(PG8_SB(1, 1), cB + hstep + kstep, voffB);
        PG8_WAIT_V(6); PG8_BAR;
    }
    for (;;) {
        const bool has_next = S.next(ui + 1, nxt);
        const char* nA = has_next ? (const char*)g.A + (size_t)nxt.pm * tstep : cA; const char* nB = has_next ? (const char*)g.Bt + (size_t)nxt.pn * tstep : cB;
        for (int t = 0; t < nt; t += 2) {
            const bool last = (t == nt - 2);
            const char* a1 = cA + (size_t)(t + 1) * kstep;
            const char* a2 = last ? nA : cA + (size_t)(t + 2) * kstep; const char* b2 = last ? nB : cB + (size_t)(t + 2) * kstep;
            const char* a3 = a2 + kstep; const char* b3 = b2 + kstep;
            if (last && has_next) S.a_ready(nxt);
            if constexpr (SP2) {
            PG8_LDB(B0, 0, 0); PG8_LDB(B1, 0, 1); PG8_SCHED; PG8_LDA(At, 0, 0); PG8_STAGE(PG8_SA(1, 1), a1 + hstep, voffA);
            PG8_WAIT_V(8); PG8_WAIT_L(0); PG8_BAR; PG8_MMA(0, 0, At, B0); PG8_MMA(0, 1, At, B1); PG8_BAR; PG8_SCHED;
            PG8_LDA(At, 0, 1); PG8_STAGE(PG8_SB(0, 0), b2, voffB); PG8_STAGE(PG8_SB(0, 1), b2 + hstep, voffB); PG8_STAGE(PG8_SA(0, 0), a2, voffA);
            PG8_WAIT_V(8); PG8_WAIT_L(0); PG8_BAR; PG8_MMA(1, 0, At, B0); PG8_MMA(1, 1, At, B1); PG8_BAR; PG8_SCHED;
            PG8_LDB(B0, 1, 0); PG8_LDB(B1, 1, 1); PG8_SCHED; PG8_LDA(At, 1, 0); PG8_STAGE(PG8_SA(0, 1), a2 + hstep, voffA);
            PG8_WAIT_V(8); PG8_WAIT_L(0); PG8_BAR; PG8_MMA(0, 0, At, B0); PG8_MMA(0, 1, At, B1); PG8_BAR; PG8_SCHED;
            PG8_LDA(At, 1, 1); PG8_STAGE(PG8_SB(1, 0), b3, voffB); PG8_STAGE(PG8_SB(1, 1), b3 + hstep, voffB); PG8_STAGE(PG8_SA(1, 0), a3, voffA);
            PG8_WAIT_V(8); PG8_WAIT_L(0); PG8_BAR; PG8_MMA(1, 0, At, B0); PG8_MMA(1, 1, At, B1); PG8_BAR; PG8_SCHED;
            } else {
            PG8_LDB(B0, 0, 0); PG8_SCHED; PG8_LDA(At, 0, 0); PG8_STAGE(PG8_SA(1, 1), a1 + hstep, voffA);
            PG8_WAIT_L(8); PG8_BAR; PG8_WAIT_L(0); PG8_MMA(0, 0, At, B0); PG8_BAR; PG8_SCHED;
            PG8_LDB(B1, 0, 1); PG8_STAGE(PG8_SB(0, 0), b2, voffB);
            PG8_BAR; PG8_WAIT_L(0); PG8_MMA(0, 1, At, B1); PG8_BAR;
            PG8_LDA(At, 0, 1); PG8_STAGE(PG8_SA(0, 0), a2, voffA);
            PG8_BAR; PG8_WAIT_L(0); PG8_MMA(1, 0, At, B0); PG8_BAR; PG8_SCHED;
            PG8_STAGE(PG8_SB(0, 1), b2 + hstep, voffB);
            PG8_WAIT_V(6); PG8_BAR; PG8_MMA(1, 1, At, B1); PG8_BAR;
            PG8_LDB(B0, 1, 0); PG8_SCHED; PG8_LDA(At, 1, 0); PG8_STAGE(PG8_SA(0, 1), a2 + hstep, voffA);
            PG8_WAIT_L(8); PG8_BAR; PG8_WAIT_L(0); PG8_MMA(0, 0, At, B0); PG8_BAR; PG8_SCHED;
            PG8_LDB(B1, 1, 1); PG8_STAGE(PG8_SB(1, 0), b3, voffB);
            PG8_BAR; PG8_WAIT_L(0); PG8_MMA(0, 1, At, B1); PG8_BAR;
            PG8_LDA(At, 1, 1); PG8_STAGE(PG8_SA(1, 0), a3, voffA);
            PG8_BAR; PG8_WAIT_L(0); PG8_MMA(1, 0, At, B0); PG8_BAR; PG8_SCHED;
            PG8_STAGE(PG8_SB(1, 1), b3 + hstep, voffB);
            PG8_WAIT_V(6); PG8_BAR; PG8_MMA(1, 1, At, B1); PG8_BAR;
            }
        }
        if constexpr (ALIGN_EPI) { if (wr == 0) PG8_BAR; }
        if constexpr (!Epi::AFTER_DRAIN) { E(acc, cur, wr, wc, fr, fq); S.done(cur); }
        if (!has_next) break;
#pragma unroll
        for (int a = 0; a < 2; ++a)
#pragma unroll
            for (int b = 0; b < 2; ++b)
#pragma unroll
                for (int m = 0; m < 4; ++m)
#pragma unroll
                    for (int n = 0; n < 2; ++n) acc[a][b][m][n] = (f32x4){0.f, 0.f, 0.f, 0.f};
        cur = nxt; cA = nA; cB = nB; ++ui;
        if constexpr (ALIGN_EPI) { if (wr == 1) PG8_BAR; }
    }
    PG8_WAIT_V(0);
    if constexpr (!ALIGN_EPI) { if (wr == 0) PG8_BAR; }
    PG8_BAR;
    if constexpr (Epi::AFTER_DRAIN) { E.fused(acc, cur, wr, wc, fr, fq, lds, wid, lane); S.done(cur); }
#undef PG8_SA
#undef PG8_SB
#undef PG8_STAGE
#undef PG8_LDA
#undef PG8_LDB
#undef PG8_MMA
#undef PG8_WAIT_V
#undef PG8_WAIT_L
#undef PG8_BAR
#undef PG8_SCHED
}
}

#ifndef PG8_SP2
#define PG8_SP2 true
#endif
#ifndef PG8_ALIGN
#define PG8_ALIGN true
#endif
#include <hip/hip_bf16.h>
#include <cmath>
namespace attn_body {
using bf16=__hip_bfloat16;
using bf16x8=__attribute__((ext_vector_type(8)))short;
using s16x4=__attribute__((ext_vector_type(4)))short;
using f32x16=__attribute__((ext_vector_type(16)))float;
using u32x4=__attribute__((ext_vector_type(4)))unsigned;
constexpr int BATCH=2,NHEAD=8,SEQ=8192,D=64,PQ=512,PVV=512,PO=1024,KPADR=128,KDEAD=112;
constexpr int NW=8,QBLK=32,QB=QBLK*NW,KVBLK=64,NQB=SEQ/QB;
constexpr int ATTN_UNIT_ROWS=QB;
__device__ __forceinline__ int crow(int r,int hi){return (r&3)+8*(r>>2)+4*hi;}
#define SBAR() __builtin_amdgcn_sched_barrier(0)
__device__ __forceinline__ void cmask(f32x16&p0,f32x16&p1,int jb,int qrel,int hi){
  const float NEG=-INFINITY; int kb=64*jb+4*hi;
  #pragma unroll
  for(int r=0;r<16;++r){int kv=kb+(r&3)+8*(r>>2); if(kv>qrel)p0[r]=NEG; if(kv+32>qrel)p1[r]=NEG;}
}

constexpr int NSLOT=3, SLOTB=8192, VSLOTB=2*SLOTB;
constexpr int LDS_K=0, LDS_V=NSLOT*SLOTB, LDS_WS=LDS_V+NSLOT*VSLOTB, LDS_OST=LDS_WS+NW*64*4, LDS_BYTES=LDS_OST+NW*4096;
constexpr float C2=0.125f*1.4426950408889634f;
__device__ __forceinline__ void glds16(const void*gsrc,unsigned lds_dst){unsigned keep;
  asm volatile("s_mov_b32 %0, m0\n\ts_mov_b32 m0, %2\n\ts_nop 0\n\tglobal_load_lds_dwordx4 %1, off\n\ts_mov_b32 m0, %0":"=&s"(keep):"v"(gsrc),"s"(lds_dst):"memory");}
__device__ __forceinline__ float max3f(float a,float b,float c){float r;asm("v_max3_f32 %0, %1, %2, %3":"=v"(r):"v"(a),"v"(b),"v"(c));return r;}
__device__ __forceinline__ float max2f(float a,float b){float r;asm("v_max_f32_e32 %0, %1, %2":"=v"(r):"v"(a),"v"(b));return r;}
__device__ __forceinline__ float fadd_s(float a,float b){float r;asm("v_add_f32_e32 %0, %1, %2":"=v"(r):"v"(a),"v"(b));return r;}
__device__ __forceinline__ float fsub_s(float a,float b){float r;asm("v_sub_f32_e32 %0, %1, %2":"=v"(r):"v"(a),"v"(b));return r;}
typedef float f32x2_t __attribute__((ext_vector_type(2))); typedef __bf16 bf16x2_t __attribute__((ext_vector_type(2)));
__device__ __forceinline__ unsigned cvtpk_s(float lo,float hi){f32x2_t v={lo,hi};bf16x2_t b=__builtin_convertvector(v,bf16x2_t);return __builtin_bit_cast(unsigned,b);}
#define WAIT_BAR(N) asm volatile("s_waitcnt vmcnt(" #N ") lgkmcnt(0)\n\ts_barrier":::"memory")

__device__ __forceinline__ void qkt(f32x16&p0,f32x16&p1,const char*Kslot,const bf16x8*qr,const f32x16&negm,int r32,int hi){
  const char*kb=Kslot+hi*1024+r32*16;
  #pragma unroll
  for(int d0=0;d0<4;++d0){
    const bf16x8 b0=*reinterpret_cast<const bf16x8*>(kb+d0*2048);
    const bf16x8 b1=*reinterpret_cast<const bf16x8*>(kb+d0*2048+512);
    if(d0==0){p0=__builtin_amdgcn_mfma_f32_32x32x16_bf16(b0,qr[0],negm,0,0,0);p1=__builtin_amdgcn_mfma_f32_32x32x16_bf16(b1,qr[0],negm,0,0,0);}
    else{p0=__builtin_amdgcn_mfma_f32_32x32x16_bf16(b0,qr[d0],p0,0,0,0);p1=__builtin_amdgcn_mfma_f32_32x32x16_bf16(b1,qr[d0],p1,0,0,0);}}
}
typedef __attribute__((address_space(3))) const char* lds_cptr;
typedef short v4i16_t __attribute__((ext_vector_type(4)));
__device__ __forceinline__ void kload8(bf16x8*kf,lds_cptr kp){
  kf[0]=*(const __attribute__((address_space(3))) bf16x8*)(kp);      kf[1]=*(const __attribute__((address_space(3))) bf16x8*)(kp+512);
  kf[2]=*(const __attribute__((address_space(3))) bf16x8*)(kp+2048); kf[3]=*(const __attribute__((address_space(3))) bf16x8*)(kp+2560);
  kf[4]=*(const __attribute__((address_space(3))) bf16x8*)(kp+4096); kf[5]=*(const __attribute__((address_space(3))) bf16x8*)(kp+4608);
  kf[6]=*(const __attribute__((address_space(3))) bf16x8*)(kp+6144); kf[7]=*(const __attribute__((address_space(3))) bf16x8*)(kp+6656);
}
__device__ __forceinline__ void kload2(bf16x8*kf,lds_cptr kp,int j){ kf[2*j]=*(const __attribute__((address_space(3))) bf16x8*)(kp+j*2048); kf[2*j+1]=*(const __attribute__((address_space(3))) bf16x8*)(kp+j*2048+512); }
__device__ __forceinline__ s16x4 vtr(lds_cptr p){ return __builtin_bit_cast(s16x4,__builtin_amdgcn_ds_read_tr16_b64_v4i16((__attribute__((address_space(3))) v4i16_t*)p)); }
__device__ __forceinline__ float rowmax(const f32x16&p0,const f32x16&p1){
  float a=max3f(p0[0],p0[1],p1[0]),b=max3f(p0[2],p0[3],p1[1]);a=max3f(a,p1[2],p1[3]);
  #pragma unroll
  for(int r=4;r<16;r+=4){a=max3f(a,p0[r],p0[r+1]);b=max3f(b,p0[r+2],p0[r+3]);a=max3f(a,p1[r],p1[r+1]);b=max3f(b,p1[r+2],p1[r+3]);}
  const float m=max2f(a,b);
  auto rr=__builtin_amdgcn_permlane32_swap(__float_as_uint(m),__float_as_uint(m),false,false);
  return max2f(__uint_as_float(rr[0]),__uint_as_float(rr[1]));
}
__device__ __forceinline__ void pv(f32x16*o,int vb,bf16x8 pa0,bf16x8 pa1,bf16x8 pa2,bf16x8 pa3){
  #pragma unroll
  for(int d0=0;d0<4;++d0){s16x4 lo[4],hi[4];
    #pragma unroll
    for(int ks=0;ks<4;++ks){
      asm volatile("ds_read_b64_tr_b16 %0,%1 offset:%c2":"=&v"(lo[ks]):"v"(vb),"i"(d0*4096+ks*1024):"memory");
      asm volatile("ds_read_b64_tr_b16 %0,%1 offset:%c2":"=&v"(hi[ks]):"v"(vb),"i"(d0*4096+ks*1024+512):"memory");}
    asm volatile("s_waitcnt lgkmcnt(0)":::"memory");SBAR();
    #define PK(k) (bf16x8){lo[k][0],lo[k][1],lo[k][2],lo[k][3],hi[k][0],hi[k][1],hi[k][2],hi[k][3]}
    o[d0]=__builtin_amdgcn_mfma_f32_32x32x16_bf16(pa0,PK(0),o[d0],0,0,0);
    o[d0]=__builtin_amdgcn_mfma_f32_32x32x16_bf16(pa1,PK(1),o[d0],0,0,0);
    o[d0]=__builtin_amdgcn_mfma_f32_32x32x16_bf16(pa2,PK(2),o[d0],0,0,0);
    o[d0]=__builtin_amdgcn_mfma_f32_32x32x16_bf16(pa3,PK(3),o[d0],0,0,0);
    #undef PK
  }
}

#ifndef ATTN_STORE16
#define ATTN_STORE16(p,v) (*(u32x4*)(p)=(v))
#endif
template<int THRL> __device__ __forceinline__ void attn_unit(int b,int h,int qb,const bf16*Q,const bf16*__restrict__ K,const bf16*__restrict__ V,bf16*O,char*shm){
  const int hq=(h>>1)*128+(h&1)*64, hv=(h>>1)*128, ho=h*128;
  int tid_=threadIdx.x; asm volatile("":"+v"(tid_));
  const int tid=tid_,lane=tid&63,r32=lane&31,hi=lane>>5; const int wid=__builtin_amdgcn_readfirstlane(tid>>6);
  const long rowbase=(long)b*SEQ; const int q0=qb*QB;
  const bf16*Qw=Q+(rowbase+q0+wid*QBLK)*PQ+hq;
  const long kvbase=(long)b*(SEQ+KPADR);
  const bf16*Kh=K+kvbase*PQ+hq,*Vh=V+kvbase*PVV+hv;
  const unsigned lds0=(unsigned)(uintptr_t)shm;
  float*wsf=(float*)(shm+LDS_WS)+wid*64;
  const bf16*ksrc=Kh+(long)lane*PQ+wid*8;
  const bf16*vsrc=Vh+(long)(16*(wid&3)+(lane>>2))*PVV+(wid>>2)*32+(lane&3)*8;
  const unsigned kdst=lds0+LDS_K+wid*1024, vdst=lds0+LDS_V+wid*1024;
  #define DMA_K(t,slot) glds16(ksrc+(long)(t)*KVBLK*PQ,(unsigned)__builtin_amdgcn_readfirstlane(kdst+(slot)))
  #define DMA_V(t,slot) do{ glds16(vsrc+(long)(t)*KVBLK*PVV,(unsigned)__builtin_amdgcn_readfirstlane(vdst+2*(slot))); glds16(vsrc+(long)(t)*KVBLK*PVV+64,(unsigned)__builtin_amdgcn_readfirstlane(vdst+2*(slot)+2*4096)); }while(0)
  const int vb0=(int)(lds0+LDS_V)+((lane>>4)&1)*32+(lane&3)*8+(4*hi+((lane&15)>>2))*64;
  const char*Kbase=shm+LDS_K; bf16x8 kf[8];
  const lds_cptr shm3=(lds_cptr)shm; const lds_cptr kp0=shm3+LDS_K+hi*1024+r32*16; const lds_cptr vp0=shm3+LDS_V+((lane>>4)&1)*32+(lane&3)*8+(4*hi+((lane&15)>>2))*64;
  const int NT=(q0+QB+KPADR)/KVBLK;
  DMA_K(0,0);DMA_V(0,0);DMA_K(1,SLOTB);
  bf16x8 qr[4];
  #pragma unroll
  for(int d0=0;d0<4;++d0)qr[d0]=*reinterpret_cast<const bf16x8*>(&Qw[(long)r32*PQ+d0*16+hi*8]);
  float mhat=0.f,l_reg=0.f;f32x16 o[4];o[0]=f32x16{};o[1]=f32x16{};o[2]=f32x16{};o[3]=f32x16{};const f32x16 zero16=f32x16{};
  const int qrel=wid*QBLK+r32;
  #define CMASK(P0,P1,t) do{int jb_=(t)-(NT-4); if(jb_>=0)cmask(P0,P1,jb_,qrel,hi);}while(0)
  bool resc=false;
  #define START(P0,P1) do{ const float rm=rowmax(P0,P1); resc=false; \
    { const float dl=rm; mhat=fadd_s(mhat,dl); \
      _Pragma("unroll") for(int r=0;r<16;++r){P0[r]=fsub_s(P0[r],dl);P1[r]=fsub_s(P1[r],dl);} \
    } \
    _Pragma("unroll") for(int r=0;r<16;++r)P0[r]=__builtin_amdgcn_exp2f(P0[r]); }while(0)
  #define RESC() do{ if(resc){ asm volatile("s_waitcnt lgkmcnt(0)":::"memory"); \
      _Pragma("unroll") for(int d_=0;d_<4;++d_) _Pragma("unroll") for(int r=0;r<16;++r)o[d_][r]*=wsf[crow(r,hi)]; } }while(0)
  f32x16 pA0,pA1,pB0,pB1;
  int sl_prev=0,sl_cur=0,sl_next=SLOTB;
  #define ROT() do{sl_prev=sl_cur;sl_cur=sl_next;sl_next=(sl_next==(NSLOT-1)*SLOTB)?0:sl_next+SLOTB;}while(0)
  DMA_K(2,2*SLOTB);
  WAIT_BAR(4);
  qkt(pA0,pA1,Kbase,qr,zero16,r32,hi);asm volatile("s_nop 15\n\ts_nop 7":"+v"(pA0),"+v"(pA1));CMASK(pA0,pA1,0);
  START(pA0,pA1);
  _Pragma("unroll") for(int r=0;r<16;++r)pA1[r]=__builtin_amdgcn_exp2f(pA1[r]);
  WAIT_BAR(0);
  DMA_K(3,0);DMA_V(1,SLOTB);
  ROT();
  kload8(kf,kp0+sl_cur);
  WAIT_BAR(3);
  s16x4 vlo[4],vhi[4]; u32x4 pw0,pw1,pw2,pw3;
  #define PKW(P,B) cvtpk_s(P[B],P[B+1])
  #define PAF(k) __builtin_bit_cast(bf16x8,pw##k)
  #define VFR(i) (bf16x8){vlo[i][0],vlo[i][1],vlo[i][2],vlo[i][3],vhi[i][0],vhi[i][1],vhi[i][2],vhi[i][3]}
  #define PIN(x) asm volatile("":"+v"(x))
  #define MX3(a,b,c) __builtin_fmaxf(__builtin_fmaxf((a),(b)),(c))
  #define GAPA(MF,A0,A1,A2,A3,W0,W1,PW) do{ MF; sacc+=A0; sacc+=A1; sacc+=A2; sacc+=A3; PIN(sacc); W0; W1; PIN(PW); SBAR(); }while(0)
  #define EX(v) __builtin_amdgcn_exp2f(v)
  #define GAPB(MF,X,B) do{ MF; X[B]=EX(X[B]); X[B+1]=EX(X[B+1]); X[B+2]=EX(X[B+2]); X[B+3]=EX(X[B+3]); PIN(X); SBAR(); }while(0)
  #define VRDH(i,cb,ks) do{ vlo[i]=vtr(vp_+((cb)*4096+(ks)*1024)); vhi[i]=vtr(vp_+((cb)*4096+(ks)*1024+512)); }while(0)
  #define KRD(G,j) do{ if(G){ kload2(kf,kp0+sl_next,j); SBAR(); } }while(0)
  #define GAPB2(MF,X,B) do{ MF; X[B]=EX(X[B]); X[B+1]=EX(X[B+1]); PIN(X); SBAR(); }while(0)
  #define PVM(ob,k,i) o[ob]=MFMA_(PAF(k),VFR(i),o[ob],0,0,0)
  #define MFMA_ __builtin_amdgcn_mfma_f32_32x32x16_bf16
  #define STEP(C0,C1,P0,P1,t,GK,GV,GL) do{ SBAR(); \
    const lds_cptr vp_=vp0+2*sl_prev; \
    VRDH(0,0,0); SBAR(); float sacc=(P0[0]+P0[1]); \
    GAPA(C0=MFMA_(kf[0],qr[0],zero16,0,0,0), P0[2],P0[3],P0[4],P0[5],     pw0[0]=PKW(P0,0), pw0[1]=PKW(P0,2), pw0); \
    VRDH(1,1,0); SBAR(); GAPA(C1=MFMA_(kf[1],qr[0],zero16,0,0,0), P0[6],P0[7],P0[8],P0[9],     pw0[2]=PKW(P0,4), pw0[3]=PKW(P0,6), pw0); \
    VRDH(2,0,1); SBAR(); GAPA(C0=MFMA_(kf[2],qr[1],C0,0,0,0),   P0[10],P0[11],P0[12],P0[13], pw1[0]=PKW(P0,8), pw1[1]=PKW(P0,10), pw1); \
    VRDH(3,1,1); SBAR(); GAPA(C1=MFMA_(kf[3],qr[1],C1,0,0,0),   P0[14],P0[15],P1[0],P1[1],   pw1[2]=PKW(P0,12),pw1[3]=PKW(P0,14), pw1); \
    GAPA(C0=MFMA_(kf[4],qr[2],C0,0,0,0),   P1[2],P1[3],P1[4],P1[5],     pw2[0]=PKW(P1,0), pw2[1]=PKW(P1,2), pw2); \
    GAPA(C1=MFMA_(kf[5],qr[2],C1,0,0,0),   P1[6],P1[7],P1[8],P1[9],     pw2[2]=PKW(P1,4), pw2[3]=PKW(P1,6), pw2); \
    GAPA(C0=MFMA_(kf[6],qr[3],C0,0,0,0),   P1[10],P1[11],P1[12],P1[13], pw3[0]=PKW(P1,8), pw3[1]=PKW(P1,10), pw3); \
    GAPA(C1=MFMA_(kf[7],qr[3],C1,0,0,0),   P1[14],P1[15],0.f,0.f,       pw3[2]=PKW(P1,12),pw3[3]=PKW(P1,14), pw3); \
    l_reg+=sacc; \
    if(GK){DMA_K((t)+3,sl_cur);} if(GV){DMA_V((t)+1,sl_next);} \
    _Pragma("unroll") for(int r=0;r<16;++r){C0[r]-=mhat;C1[r]-=mhat;}   \
    CMASK(C0,C1,t); \
    { float a=MX3(C0[0],C0[1],C1[0]),b=MX3(C0[2],C0[3],C1[1]); a=MX3(a,C1[2],C1[3]); \
      _Pragma("unroll") for(int r=4;r<16;r+=4){a=MX3(a,C0[r],C0[r+1]);b=MX3(b,C0[r+2],C0[r+3]);a=MX3(a,C1[r],C1[r+1]);b=MX3(b,C1[r+2],C1[r+3]);} \
      float rm=__builtin_fmaxf(a,b); { auto rr=__builtin_amdgcn_permlane32_swap(__float_as_uint(rm),__float_as_uint(rm),false,false); rm=__builtin_fmaxf(__uint_as_float(rr[0]),__uint_as_float(rr[1])); } \
      resc=false; \
      if(__builtin_expect(__any(rm>(float)THRL),0)){ const float dl=__builtin_fmaxf(rm,0.f); mhat+=dl; \
        _Pragma("unroll") for(int r=0;r<16;++r){C0[r]-=dl;C1[r]-=dl;} \
        const float f=__builtin_amdgcn_exp2f(-dl); l_reg*=f; if(hi==0)wsf[r32]=f; resc=true; } } \
    SBAR(); \
    GAPB2(PVM(0,0,0), C0,0);  VRDH(0,0,2); SBAR(); \
    GAPB2(PVM(1,0,1), C0,2);  VRDH(1,1,2); SBAR(); \
    GAPB2(PVM(0,1,2), C0,4);  VRDH(2,0,3); SBAR(); \
    GAPB2(PVM(1,1,3), C0,6);  VRDH(3,1,3); SBAR(); \
    KRD(GL,0); GAPB2(PVM(0,2,0), C0,8);  VRDH(0,2,0); SBAR(); \
    GAPB2(PVM(1,2,1), C0,10); VRDH(1,3,0); SBAR(); \
    KRD(GL,1); GAPB2(PVM(0,3,2), C0,12); VRDH(2,2,1); SBAR(); \
    GAPB2(PVM(1,3,3), C0,14); VRDH(3,3,1); SBAR(); \
    KRD(GL,2); GAPB2(PVM(2,0,0), C1,0);  VRDH(0,2,2); SBAR(); \
    GAPB2(PVM(3,0,1), C1,2);  VRDH(1,3,2); SBAR(); \
    KRD(GL,3); GAPB2(PVM(2,1,2), C1,4);  VRDH(2,2,3); SBAR(); \
    GAPB2(PVM(3,1,3), C1,6);  VRDH(3,3,3); SBAR(); \
    GAPB2(PVM(2,2,0), C1,8); \
    GAPB2(PVM(3,2,1), C1,10); \
    GAPB2(PVM(2,3,2), C1,12); \
    GAPB2(PVM(3,3,3), C1,14); \
    }while(0)
  int t=1;
  #undef CMASK
  #define CMASK(P0,P1,t) do{}while(0)
  for(;t+5<NT;t+=2){
    STEP(pB0,pB1,pA0,pA1,t,true,true,true);     WAIT_BAR(3); RESC(); ROT();
    STEP(pA0,pA1,pB0,pB1,t+1,true,true,true);   WAIT_BAR(3); RESC(); ROT();
  }
  #undef CMASK
  #define CMASK(P0,P1,t) do{int jb_=(t)-(NT-4); if(jb_>=0)cmask(P0,P1,jb_,qrel,hi);}while(0)
  #define ENDW(tt) do{ if((tt)+3<NT){WAIT_BAR(3);} else if((tt)+2<NT){WAIT_BAR(2);} else {WAIT_BAR(0);} }while(0)
  for(;t+1<NT;t+=2){
    STEP(pB0,pB1,pA0,pA1,t,(t+3<NT),(t+1<NT),(t+1<NT));       ENDW(t);   RESC(); ROT();
    STEP(pA0,pA1,pB0,pB1,t+1,(t+4<NT),(t+2<NT),(t+2<NT));     ENDW(t+1); RESC(); ROT();
  }
  STEP(pB0,pB1,pA0,pA1,NT-1,false,false,false); RESC();
  { float sacc=pB0[0]+pB0[1]; _Pragma("unroll") for(int r=2;r<16;++r)sacc+=pB0[r]; _Pragma("unroll") for(int r=0;r<16;++r)sacc+=pB1[r]; l_reg+=sacc;
    pw0=(u32x4){PKW(pB0,0),PKW(pB0,2),PKW(pB0,4),PKW(pB0,6)};pw1=(u32x4){PKW(pB0,8),PKW(pB0,10),PKW(pB0,12),PKW(pB0,14)};pw2=(u32x4){PKW(pB1,0),PKW(pB1,2),PKW(pB1,4),PKW(pB1,6)};pw3=(u32x4){PKW(pB1,8),PKW(pB1,10),PKW(pB1,12),PKW(pB1,14)};
    SBAR(); pv(o,vb0+2*sl_cur,PAF(0),PAF(1),PAF(2),PAF(3)); }
  #undef PKW
  #undef PAF
  #undef VFR
  #undef PIN
  #undef MX3
  #undef GAPA
  #undef GAPB
  #undef GAPB2
  #undef PVM
  #undef MFMA_
  #undef VRDH
  #undef EX
  #undef KRD
  #undef STEP
  #undef ENDW
  {auto rr=__builtin_amdgcn_permlane32_swap(__float_as_uint(l_reg),__float_as_uint(l_reg),false,false);l_reg=__uint_as_float(rr[0])+__uint_as_float(rr[1]);}
  l_reg-=(float)KDEAD*__builtin_amdgcn_exp2f(-mhat);
  if(hi==0)wsf[32+r32]=l_reg;asm volatile("s_waitcnt lgkmcnt(0)":::"memory");
  float rli[16];
  #pragma unroll
  for(int r=0;r<16;++r)rli[r]=__builtin_amdgcn_rcpf(wsf[32+crow(r,hi)]);
  const __amdgpu_buffer_rsrc_t orsrc=__builtin_amdgcn_make_buffer_rsrc(O,0,(int)(2u*SEQ*PO*2u),0x00020000);
  { int le=threadIdx.x&63; asm volatile("":"+v"(le)); const int lane=le; int sbase=4*(le>>5)*64+(le&31);
    bf16*stg=(bf16*)(shm+LDS_OST)+wid*2048;
    #pragma unroll
    for(int ps=0;ps<2;++ps){
      #pragma unroll
      for(int r=0;r<16;++r){
        #pragma unroll
        for(int d0=0;d0<2;++d0)stg[sbase+((r&3)+8*(r>>2))*64+d0*32]=__float2bfloat16(o[2*ps+d0][r]*rli[r]);}
      asm volatile("s_waitcnt lgkmcnt(0)":::"memory");
      #pragma unroll
      for(int i=0;i<4;++i){const int row=i*8+(lane>>3),ch=lane&7; const u32x4 v=*(const u32x4*)(stg+row*64+ch*8); __builtin_amdgcn_raw_buffer_store_b128(v,orsrc,(unsigned)(((rowbase+q0+wid*QBLK+row)*PO+ho+ps*64+ch*8)*2),0,16);}
      asm volatile("s_waitcnt lgkmcnt(0)":::"memory"); } }
  asm volatile("s_waitcnt lgkmcnt(0)\n\ts_barrier":::"memory");
  #undef DMA_K
  #undef DMA_V
  #undef CMASK
  #undef START
  #undef RESC
  #undef ROT
}
constexpr int ATTN_LDS_BYTES=LDS_BYTES;
struct AttnTensors { const bf16* Q; const bf16* K; const bf16* V; bf16* O; };
struct AttnUnit { int bh; int qb; };
struct StaticOrder {
  int vcu;
  __device__ __forceinline__ explicit StaticOrder(int grid,int block):vcu((block%8)*(grid/8)+block/8){}
  __device__ __forceinline__ bool next(int i,AttnUnit&u)const{ if(i>=2)return false; const int s=vcu&15; u.bh=vcu>>4; u.qb=(i==0)?s:31-s; return true; }
  __device__ __forceinline__ void a_ready(const AttnUnit&)const{}
  __device__ __forceinline__ void done(const AttnUnit&)const{}
};
template<class Sched,int THRL=8> __device__ __forceinline__ void attn_phase(char*lds,const AttnTensors&T,const Sched&S){
  AttnUnit u;
  for(int i=0;S.next(i,u);++i){ S.a_ready(u); attn_unit<THRL>(u.bh/NHEAD,u.bh%NHEAD,u.qb,T.Q,T.K,T.V,T.O,lds); S.done(u); }
}
#undef SBAR
#undef WAIT_BAR
}
#include <hip/hip_cooperative_groups.h>
namespace cg = cooperative_groups;
constexpr int NWAVES = 8;
constexpr int T = 8192, D = 1024, NMETA = 16, MR = 2 * T  , MA = MR + NMETA  ;
constexpr int NIN = 2048, DFF = 2816, NUP = 2 * DFF;
constexpr int KPAD = 128, TP = T + KPAD;
constexpr float EPS = 1e-6f;
constexpr float LAM_INIT = 0.2f;
constexpr size_t MiB = 1u << 20;
constexpr size_t WS_WIN = 2 * MiB, WS_WO = 6 * MiB, WS_WUP = 8 * MiB, WS_WDN = 19 * MiB;
constexpr size_t WS_BPART = 25 * MiB, WS_BEFF = WS_BPART + 65536, WS_H1M = WS_BEFF + 4096, WS_UM = WS_H1M + 65536;
constexpr size_t WS_XNM = 25 * MiB + 512 * 1024;
constexpr size_t WS_SSQ = 26 * MiB, WS_LSE = 27 * MiB;
constexpr size_t WS_XN = 28 * MiB;
constexpr size_t WS_MIX = 60 * MiB;
constexpr size_t WS_HRAW = 93 * MiB;
constexpr size_t WS_U = 116 * MiB, SPLIT_STRIDE_B = 17 * MiB;
constexpr size_t WS_Q = WS_U + SPLIT_STRIDE_B, WS_K = WS_Q + SPLIT_STRIDE_B, WS_V = WS_K + SPLIT_STRIDE_B;
constexpr size_t WS_O = 184 * MiB;
constexpr size_t WS_ACT = 116 * MiB;
constexpr size_t WS_END = 216 * MiB;
static_assert(WS_UM + 16 * NUP * 4 <= WS_SSQ && WS_HRAW + (size_t)256 * 4 * NUP * 4 <= WS_U && WS_ACT + (size_t)MR * DFF * 2 <= WS_END && WS_MIX + (size_t)MA * D * 2 <= WS_HRAW && (size_t)2 * TP * 512 * 2 <= SPLIT_STRIDE_B, "ws map");
constexpr int LDS_BYTES = 147456, RING_OFF = 0;

#define LAS __attribute__((address_space(3)))
typedef unsigned short bf16;
typedef unsigned v4u __attribute__((ext_vector_type(4)));
typedef float f32x4 __attribute__((ext_vector_type(4)));
typedef short bf16x8 __attribute__((ext_vector_type(8)));
__device__ __forceinline__ unsigned f2bf(float f) { unsigned u = __builtin_bit_cast(unsigned, f); return (u + 0x7fffu + ((u >> 16) & 1u)) >> 16; }
__device__ __forceinline__ unsigned pk2(float lo, float hi) { return f2bf(lo) | (f2bf(hi) << 16); }
__device__ __forceinline__ float bflo(unsigned w) { return __builtin_bit_cast(float, w << 16); }
__device__ __forceinline__ float bfhi(unsigned w) { return __builtin_bit_cast(float, w & 0xffff0000u); }
__device__ __forceinline__ void unpack8(const v4u w, float (&f)[8]) { f[0] = bflo(w.x); f[1] = bfhi(w.x); f[2] = bflo(w.y); f[3] = bfhi(w.y); f[4] = bflo(w.z); f[5] = bfhi(w.z); f[6] = bflo(w.w); f[7] = bfhi(w.w); }
__device__ __forceinline__ float wave_sum(float v) {
#pragma unroll
    for (int o = 1; o < 64; o <<= 1) v += __shfl_xor(v, o);
    return v;
}
typedef __attribute__((address_space(1))) unsigned gu32;
#define XB_TMO      128
#define XB_XCNT(j)  (256  + 64 * (j))
#define XB_XSUB(j)  (1280 + 64 * (j))
#define XB_XGEN(j)  (2304 + 64 * (j))
#define XB_TOP      3328
#define XB_TOPGEN   3392
#define XCD_BAR_WORDS 3456
#define XB_SPIN_CAP (1u << 18)

__device__ __forceinline__ unsigned xb_ld(unsigned* p)              { return __hip_atomic_load(p, __ATOMIC_RELAXED, __HIP_MEMORY_SCOPE_AGENT); }
__device__ __forceinline__ unsigned xb_add(unsigned* p, unsigned v) { return __hip_atomic_fetch_add(p, v, __ATOMIC_RELAXED, __HIP_MEMORY_SCOPE_AGENT); }
__device__ __forceinline__ unsigned xb_xcc_id() { return (unsigned)__builtin_amdgcn_s_getreg((3 << 11) | 20) & 0xFu; }
#define XB_SPIN(cond, bar) do { unsigned _sp = 0; while (cond) { __builtin_amdgcn_s_sleep(1); \
    if ((++_sp & 255u) == 0u) { if (xb_ld(&(bar)[XB_TMO])) break; if (_sp > XB_SPIN_CAP) { atomicAdd(&(bar)[XB_TMO], 1u); break; } } } } while (0)

struct XcdBarrier {
    unsigned* bar; unsigned x;
    volatile LAS unsigned* st;
};

__device__ __forceinline__ XcdBarrier xcd_barrier_post(unsigned* bar, volatile LAS unsigned* st) {
    XcdBarrier b; b.bar = bar; b.x = xb_xcc_id(); b.st = st;
    if (threadIdx.x == 0) (void)xb_add(&bar[XB_XCNT(b.x)], 1u);
    return b;
}
__device__ __forceinline__ void xcd_barrier_complete(unsigned* bar, unsigned x, unsigned& nloc, unsigned& nx) {
    const unsigned G = gridDim.x * gridDim.y * gridDim.z;
    unsigned sum, cnt, mine, sp = 0u;
    for (;;) {
        sum = 0u; cnt = 0u; mine = 0u;
#pragma unroll
        for (unsigned j = 0; j < 16; ++j) { const unsigned c = xb_ld(&bar[XB_XCNT(j)]); sum += c; cnt += (c > 0u) ? 1u : 0u; mine = (j == x) ? c : mine; }
        if (sum == G) break;
        __builtin_amdgcn_s_sleep(1);
        if ((++sp & 255u) == 0u) { if (xb_ld(&bar[XB_TMO])) break; if (sp > XB_SPIN_CAP) { atomicAdd(&bar[XB_TMO], 1u); break; } }
    }
    nloc = mine > 0u ? mine : 1u; nx = cnt > 0u ? cnt : 1u;
}

__device__ __forceinline__ void xcd_barrier(const XcdBarrier& b) {
    asm volatile("s_waitcnt vmcnt(0)" ::: "memory");
    __syncthreads();
    if (threadIdx.x == 0) {
        unsigned* bar = b.bar;
        __builtin_amdgcn_s_waitcnt(0);
        unsigned nloc = b.st[0], nx = b.st[1];
        if (nloc == 0u) { xcd_barrier_complete(bar, b.x, nloc, nx); b.st[0] = nloc; b.st[1] = nx; }
        const unsigned old = xb_add(&bar[XB_XSUB(b.x)], 1u);
        const unsigned gen = old / nloc;
        if (old + 1u == (gen + 1u) * nloc) {
            __builtin_amdgcn_fence(__ATOMIC_RELEASE, "agent");
            asm volatile("s_waitcnt vmcnt(0)" ::: "memory");
            const unsigned og = xb_add(&bar[XB_TOP], 1u);
            const unsigned tg = og / nx;
            if (og + 1u == (tg + 1u) * nx) xb_add(&bar[XB_TOPGEN], 1u);
            else XB_SPIN(xb_ld(&bar[XB_TOPGEN]) == tg, bar);
            __builtin_amdgcn_fence(__ATOMIC_ACQUIRE, "agent");
            xb_add(&bar[XB_XGEN(b.x)], 1u);
            asm volatile("s_waitcnt vmcnt(0)" ::: "memory");
        } else {
            XB_SPIN(xb_ld(&bar[XB_XGEN(b.x)]) == gen, bar);
            __builtin_amdgcn_fence(__ATOMIC_ACQUIRE, "agent");
            asm volatile("s_waitcnt vmcnt(0)" ::: "memory");
        }
    }
    __syncthreads();
}

constexpr size_t WS_BAR = 16384;
constexpr int MISC_OFF = 131072 + 320;
struct Args { const float* in[20]; float* out; unsigned char* ws; };
enum { I_X = 0, I_META, I_GMIX, I_WIN, I_WPOOL, I_BPOOL, I_PSCALE, I_QG, I_KG, I_LQ1, I_LK1, I_LQ2, I_LK2, I_SUBG, I_WOUT, I_GFFN, I_WUP, I_CONVW, I_CONVB, I_WDOWN };

__device__ __forceinline__ void transpose_item(const float* W, int N, int ksrc0, int n0, bf16* WT, int ldt, int drow0, int kdst0, LAS float* scr, int lane, const float* kgain = nullptr) {
    float tv[32];
#pragma unroll
    for (int i = 0; i < 32; ++i) tv[i] = W[(size_t)(ksrc0 + 2 * i + (lane >> 5)) * N + n0 + (lane & 31)];
    if (kgain) {
#pragma unroll
        for (int i = 0; i < 32; ++i) tv[i] *= kgain[ksrc0 + 2 * i + (lane >> 5)]; }
#pragma unroll
    for (int i = 0; i < 32; ++i) scr[(2 * i + (lane >> 5)) * 33 + (lane & 31)] = tv[i];
    asm volatile("s_waitcnt lgkmcnt(0)" ::: "memory");
    const int c = lane & 7; const __amdgpu_buffer_rsrc_t wtr = __builtin_amdgcn_make_buffer_rsrc(WT, 0, 16 << 20, 0x00020000);
#pragma unroll
    for (int j = 0; j < 4; ++j) { const int n = (lane >> 3) + 8 * j; const LAS float* s = scr + (8 * c) * 33 + n;
        v4u o; o.x = pk2(s[0 * 33], s[1 * 33]); o.y = pk2(s[2 * 33], s[3 * 33]); o.z = pk2(s[4 * 33], s[5 * 33]); o.w = pk2(s[6 * 33], s[7 * 33]);
        __builtin_amdgcn_raw_buffer_store_b128(o, wtr, (unsigned)(((drow0 + n) * ldt + kdst0 + 8 * c) * 2), 0, 16); }
    asm volatile("s_waitcnt lgkmcnt(0)" ::: "memory");
}
template <bool A_BF16, class Epi> __device__ __forceinline__ void meta_tiles(int first, int ntiles, const void* A, int lda, const float* gain, const bf16* Bt, int K, LAS float* scr, int lane, int wave, const Epi& epi) {
    const int r = lane & 15, q = lane >> 4, kc = K / 8;
    for (int tile = first; tile < ntiles; tile += 256) { const int n0 = tile * 16; f32x4 acc = {0.f, 0.f, 0.f, 0.f}; float ss = 0.f;
#pragma unroll 4
        for (int k0 = wave * kc; k0 < wave * kc + kc; k0 += 32) { const int kk = k0 + 8 * q; bf16x8 a;
            if constexpr (A_BF16) a = *(const bf16x8*)((const bf16*)A + (size_t)r * lda + kk);
            else { f32x4 x0 = *(const f32x4*)((const float*)A + (size_t)r * lda + kk), x1 = *(const f32x4*)((const float*)A + (size_t)r * lda + kk + 4);
                ss += (x0[0] * x0[0] + x0[1] * x0[1]) + (x0[2] * x0[2] + x0[3] * x0[3]) + (x1[0] * x1[0] + x1[1] * x1[1]) + (x1[2] * x1[2] + x1[3] * x1[3]);
                if (gain) { x0 = x0 * *(const f32x4*)(gain + kk); x1 = x1 * *(const f32x4*)(gain + kk + 4); }
                v4u w; w.x = pk2(x0[0], x0[1]); w.y = pk2(x0[2], x0[3]); w.z = pk2(x1[0], x1[1]); w.w = pk2(x1[2], x1[3]); a = __builtin_bit_cast(bf16x8, w); }
            const bf16x8 b = *(const bf16x8*)(Bt + (size_t)(n0 + r) * K + kk);
            acc = __builtin_amdgcn_mfma_f32_16x16x32_bf16(a, b, acc, 0, 0, 0); }
        ss += __shfl_xor(ss, 16); ss += __shfl_xor(ss, 32);
        LAS float* p = scr + (wave * 64 + lane) * 5; p[0] = acc[0]; p[1] = acc[1]; p[2] = acc[2]; p[3] = acc[3]; p[4] = ss;
        __syncthreads();
        if (wave == 0) { f32x4 t = {0.f, 0.f, 0.f, 0.f}; float st = 0.f;
#pragma unroll
            for (int w = 0; w < 8; ++w) { const LAS float* pw = scr + (w * 64 + lane) * 5; t[0] += pw[0]; t[1] += pw[1]; t[2] += pw[2]; t[3] += pw[3]; st += pw[4]; }
            epi(t, st, n0); }
        __syncthreads(); }
}

#ifndef REP_SYNC
#define REP_SYNC 1
#endif
#ifndef REP_P0
#define REP_P0 1
#endif
#ifndef REP_P1
#define REP_P1 1
#endif
#ifndef REP_P2
#define REP_P2 1
#endif
#ifndef REP_P2H
#define REP_P2H 1
#endif
#ifndef REP_P3
#define REP_P3 1
#endif
#ifndef REP_P4
#define REP_P4 1
#endif
#ifndef REP_P4H
#define REP_P4H 1
#endif
#ifndef REP_P5
#define REP_P5 1
#endif
#define GRID_SYNC() do { _Pragma("unroll 1") for (int rs_ = 0; rs_ < REP_SYNC; ++rs_) { XcdBarrier b_; b_.bar = (unsigned*)(args.ws + WS_BAR); b_.x = xb_xcc_id(); b_.st = (volatile LAS unsigned*)((LAS unsigned char*)lds + MISC_OFF) + 8; xcd_barrier(b_); } } while (0)
#define PHASE_IDS() unsigned char* ws = args.ws; int tid = threadIdx.x; asm volatile("" : "+v"(tid)); const int lane = tid & 63, wave = __builtin_amdgcn_readfirstlane(tid >> 6); \
    int bx = blockIdx.x; asm volatile("" : "+s"(bx)); const int G = 256, vcu = (bx % 8) * (G / 8) + bx / 8, gw = vcu * NWAVES + wave, NGW = G * NWAVES; (void)lane; (void)gw; (void)NGW; (void)ws
__global__ void __launch_bounds__(NWAVES * 64, 2) hymba_fwd(Args args) {
    extern __shared__ __attribute__((aligned(16))) unsigned char lds[];
    cg::grid_group grid = cg::this_grid();
    LAS unsigned char* ldsl = (LAS unsigned char*)lds;
    {
        if (threadIdx.x < 32) ((volatile LAS unsigned*)(ldsl + MISC_OFF))[threadIdx.x] = 0u;
        __syncthreads();
        (void)xcd_barrier_post((unsigned*)(args.ws + WS_BAR), (volatile LAS unsigned*)(ldsl + MISC_OFF) + 8);
        if (args.out == nullptr) grid.sync();
    }

#pragma unroll 1
    for (int rep_ = 0; rep_ < REP_P0; ++rep_) {
        PHASE_IDS();
        bf16* Win_t = (bf16*)(ws + WS_WIN); bf16* Wo_t = (bf16*)(ws + WS_WO); bf16* Wup_t = (bf16*)(ws + WS_WUP); bf16* Wdn_t = (bf16*)(ws + WS_WDN); float* BPART = (float*)(ws + WS_BPART); bf16* XN = (bf16*)(ws + WS_XN); const float* x = args.in[I_X];
        LAS float* scr = (LAS float*)(ldsl + RING_OFF + wave * 16384);
        constexpr int I_IN = (D / 64) * (NIN / 32), I_O = (512 / 64) * (D / 32), I_UP = (D / 64) * (NUP / 32), I_DN = 0;
        constexpr int I_FOLD = 4 * 16 * 16, I_BP = 16 * 16, NITEMS = I_FOLD + I_IN + I_O + I_UP + I_DN + I_BP;
        const float* gm = args.in[I_GMIX];
        if (gw < NMETA) {
            const f32x4* xr = (const f32x4*)(args.in[I_META] + (size_t)gw * D) + lane; f32x4 v[4]; float sm = 0.f;
#pragma unroll
            for (int j = 0; j < 4; ++j) { v[j] = xr[64 * j]; sm += (v[j].x * v[j].x + v[j].y * v[j].y) + (v[j].z * v[j].z + v[j].w * v[j].w); }
            const float rm = 1.0f / sqrtf(wave_sum(sm) * (1.0f / D) + EPS); unsigned long long* om = (unsigned long long*)((bf16*)(ws + WS_XNM) + (size_t)gw * D) + lane;
#pragma unroll
            for (int j = 0; j < 4; ++j) { const f32x4 gg = ((const f32x4*)gm)[lane + 64 * j]; const f32x4 y = v[j] * rm * gg; om[64 * j] = (unsigned long long)pk2(y.x, y.y) | ((unsigned long long)pk2(y.z, y.w) << 32); }
        }
        for (int m = gw; m < MR; m += 2 * NGW) {
            const f32x4* xa = (const f32x4*)(x + (size_t)m * D) + lane; const f32x4* xb = (const f32x4*)(x + (size_t)(m + NGW) * D) + lane; f32x4 va[4], vb[4]; float sa = 0.f, sb = 0.f;
#pragma unroll
            for (int j = 0; j < 4; ++j) { va[j] = __builtin_nontemporal_load(xa + 64 * j); vb[j] = __builtin_nontemporal_load(xb + 64 * j); }
#pragma unroll
            for (int j = 0; j < 4; ++j) { sa += (va[j].x * va[j].x + va[j].y * va[j].y) + (va[j].z * va[j].z + va[j].w * va[j].w); sb += (vb[j].x * vb[j].x + vb[j].y * vb[j].y) + (vb[j].z * vb[j].z + vb[j].w * vb[j].w); }
#pragma unroll
            for (int o = 1; o < 64; o <<= 1) { sa += __shfl_xor(sa, o); sb += __shfl_xor(sb, o); }
            const float ra = 1.0f / sqrtf(sa * (1.0f / D) + EPS), rb = 1.0f / sqrtf(sb * (1.0f / D) + EPS);
            unsigned long long* oa = (unsigned long long*)(XN + (size_t)m * D) + lane; unsigned long long* ob = (unsigned long long*)(XN + (size_t)(m + NGW) * D) + lane;
#pragma unroll
            for (int j = 0; j < 4; ++j) { const f32x4 gg = ((const f32x4*)gm)[lane + 64 * j]; const f32x4 ya = va[j] * ra * gg, yb = vb[j] * rb * gg;
                oa[64 * j] = (unsigned long long)pk2(ya.x, ya.y) | ((unsigned long long)pk2(ya.z, ya.w) << 32); ob[64 * j] = (unsigned long long)pk2(yb.x, yb.y) | ((unsigned long long)pk2(yb.z, yb.w) << 32); }
        }
            for (int c = bx * (NWAVES * 64) + tid; c < 2 * 2 * (KPAD - NMETA) * 64; c += G * NWAVES * 64) {
            const int ch = c & 63, row = (c >> 6) % (KPAD - NMETA), bb = ((c >> 6) / (KPAD - NMETA)) & 1, which = (c >> 6) / (2 * (KPAD - NMETA));
            *(v4u*)((bf16*)(ws + (which ? WS_V : WS_K)) + (size_t)(bb * TP + row) * 512 + ch * 8) = (v4u){0u, 0u, 0u, 0u}; }
        for (int it = wave * G + vcu; it < NITEMS; it += NGW) {
            int r = it;
            if (r < I_FOLD) {
                const int g = r >> 8, cc = (r >> 4) & 15, nb = r & 15, n = nb * 64 + lane, c0 = cc * 8;
                const float* Wp = args.in[I_WPOOL] + (size_t)(g * 128 + c0) * 128; const float* ps = args.in[I_PSCALE] + g * 128; const float* Wo = args.in[I_WOUT] + (size_t)(g * 128) * D + n;
                float a8[8] = {0.f, 0.f, 0.f, 0.f, 0.f, 0.f, 0.f, 0.f};
#pragma unroll 32
                for (int d = 0; d < 128; ++d) { const float w = Wo[(size_t)d * D] * ps[d];
#pragma unroll
                    for (int i = 0; i < 8; ++i) a8[i] += Wp[i * 128 + d] * w; }
                v4u o; o.x = pk2(a8[0], a8[1]); o.y = pk2(a8[2], a8[3]); o.z = pk2(a8[4], a8[5]); o.w = pk2(a8[6], a8[7]);
                *(v4u*)(Wo_t + (size_t)n * D + g * 128 + c0) = o; continue; }
            r -= I_FOLD;
            if (r < I_IN) { const int nblk = NIN / 32, kb = r / nblk, nb = r % nblk, n0 = 32 * nb;
                const int drow = (n0 >= 512 && n0 < 1536) ? (n0 & ~255) + 128 * ((n0 >> 5) & 1) + 32 * ((n0 & 255) >> 6) : n0;
                transpose_item(args.in[I_WIN], NIN, 64 * kb, n0, Win_t, D, drow, 64 * kb, scr, lane); continue; }
            r -= I_IN;
            if (r < I_O) { const int nblk = D / 32, kb = r / nblk, nb = r % nblk; transpose_item(args.in[I_WOUT], D, 512 + 64 * kb, 32 * nb, Wo_t, D, 32 * nb, 512 + 64 * kb, scr, lane); continue; }
            r -= I_O;
            if (r < I_UP) { const int nblk = NUP / 32, kb = r / nblk, nb = r % nblk, n0 = 32 * nb; const int j = n0 < DFF ? n0 : n0 - DFF; const int drow = (j >> 7) * 256 + (j & 127) + (n0 < DFF ? 0 : 128);
                transpose_item(args.in[I_WUP], NUP, 64 * kb, n0, Wup_t, D, drow, 64 * kb, scr, lane, args.in[I_GFFN]); continue; }
            r -= I_UP;
            {
                const int kc = r >> 4, nb = r & 15, n = nb * 64 + lane; float a = 0.f;
#pragma unroll
                for (int k = kc * 32; k < kc * 32 + 32; ++k) a += args.in[I_BPOOL][k] * args.in[I_PSCALE][k] * args.in[I_WOUT][(size_t)k * D + n];
                BPART[kc * D + n] = a; }
        }
}
    GRID_SYNC();

#pragma unroll 1
    for (int rep_ = 0; rep_ < REP_P1; ++rep_) {
        PHASE_IDS();
        bf16* Win_t = (bf16*)(ws + WS_WIN); bf16* XN = (bf16*)(ws + WS_XN); bf16* UB = (bf16*)(ws + WS_U); const float* meta = args.in[I_META];
        if (bx == 255) { const float* BPART = (const float*)(ws + WS_BPART); float* BEFF = (float*)(ws + WS_BEFF);
            for (int n = tid; n < D; n += NWAVES * 64) { float a = 0.f;
#pragma unroll
                for (int kc = 0; kc < 16; ++kc) a += BPART[kc * D + n]; BEFF[n] = a; } }
        if (bx < NIN / 64) {
            LAS float* scr = (LAS float*)(ldsl + RING_OFF);
            const int grp = bx, tsec = grp >> 3, j = wave >> 1, r = lane & 15, q = lane >> 4;
            const bool qk = (tsec == 1 || tsec == 2);
            const int brow = qk ? ((grp * 64) & ~255) + 32 * (grp & 3) + (j & 1) * 16 + (j >> 1) * 128 : grp * 64 + 16 * j;
            f32x4 acc = {0.f, 0.f, 0.f, 0.f}; float ss = 0.f; const bf16* xnm = (const bf16*)(ws + WS_XNM);
            {
                bf16x8 av[16], bw[16]; const int kb = (wave & 1) * 512 + 8 * q;
#pragma unroll
                for (int it = 0; it < 16; ++it) { av[it] = *(const bf16x8*)(xnm + (size_t)r * D + kb + 32 * it); bw[it] = *(const bf16x8*)(Win_t + (size_t)(brow + r) * D + kb + 32 * it); }
#pragma unroll
                for (int it = 0; it < 16; ++it) acc = __builtin_amdgcn_mfma_f32_16x16x32_bf16(av[it], bw[it], acc, 0, 0, 0);
            }
            ss += __shfl_xor(ss, 16); ss += __shfl_xor(ss, 32);
            { LAS float* p = scr + (wave * 64 + lane) * 5; p[0] = acc[0]; p[1] = acc[1]; p[2] = acc[2]; p[3] = acc[3]; p[4] = ss; }
            __syncthreads();
            if (wave == 0) {
                const float rstd = 1.0f;
                float rsr[4];
#pragma unroll
                for (int jj = 0; jj < 4; ++jj) rsr[jj] = __shfl(rstd, 4 * q + jj);
                float val[4][4], s2[4] = {0.f, 0.f, 0.f, 0.f};
#pragma unroll
                for (int tj = 0; tj < 4; ++tj)
#pragma unroll
                    for (int jj = 0; jj < 4; ++jj) { const float v = (scr[((2 * tj) * 64 + lane) * 5 + jj] + scr[((2 * tj + 1) * 64 + lane) * 5 + jj]) * rsr[jj]; val[tj][jj] = v; s2[jj] += v * v; }
                const float* gp = (tsec == 1) ? args.in[I_QG] : args.in[I_KG]; const float sc = (tsec == 1) ? attn_body::C2 : 1.0f;
                bf16* base = (bf16*)(ws + WS_U + (size_t)tsec * SPLIT_STRIDE_B);
#pragma unroll
                for (int jj = 0; jj < 4; ++jj) { float rn = 1.0f;
                    if (qk) { float t2 = s2[jj]; t2 += __shfl_xor(t2, 1); t2 += __shfl_xor(t2, 2); t2 += __shfl_xor(t2, 4); t2 += __shfl_xor(t2, 8); rn = sc / sqrtf(t2 * (1.0f / 64.0f) + EPS); }
                    const int row = 4 * q + jj;
#pragma unroll
                    for (int tj = 0; tj < 4; ++tj) { const int c64 = 16 * tj + r, cc = (grp & 7) * 64 + c64; const bf16 v = (bf16)f2bf(val[tj][jj] * rn * (qk ? gp[c64] : 1.0f));
                        if (tsec < 2) base[(size_t)(MR + row) * 512 + cc] = v; else { base[(size_t)(KPAD - NMETA + row) * 512 + cc] = v; base[(size_t)(TP + KPAD - NMETA + row) * 512 + cc] = v; } } }
            }
            __syncthreads();
        }
        pg8::Gemm g{XN, Win_t, MR, NIN, D}; pg8::StaticOrder S; S.init(MR, NIN, G, bx);
        pg8::EpiQKV E{UB, SPLIT_STRIDE_B / 2, KPAD, args.in[I_QG], args.in[I_KG], attn_body::C2};
        pg8::gemm_phase<pg8::EpiQKV, pg8::StaticOrder, PG8_ALIGN, PG8_SP2>(ldsl + RING_OFF, g, S, E);
    }
    GRID_SYNC();


#pragma unroll 1
    for (int rep_ = 0; rep_ < REP_P2; ++rep_) {
        PHASE_IDS();
        bf16* QB_ = (bf16*)(ws + WS_Q); bf16* KB = (bf16*)(ws + WS_K); bf16* VB = (bf16*)(ws + WS_V); bf16* OB = (bf16*)(ws + WS_O); float* LSE = (float*)(ws + WS_LSE);
        const attn_body::AttnTensors AT{(const attn_body::bf16*)QB_, (const attn_body::bf16*)KB, (const attn_body::bf16*)VB, (attn_body::bf16*)OB};
        const attn_body::StaticOrder S(G, bx);
        attn_body::attn_phase<attn_body::StaticOrder>((char*)lds + RING_OFF, AT, S);
    }
    GRID_SYNC();

#pragma unroll 1
    for (int rep_ = 0; rep_ < REP_P2H; ++rep_) {
        PHASE_IDS();
        bf16* UB = (bf16*)(ws + WS_U); bf16* QB_ = (bf16*)(ws + WS_Q); bf16* KB = (bf16*)(ws + WS_K); bf16* VB = (bf16*)(ws + WS_V); bf16* OB = (bf16*)(ws + WS_O); float* LSE = (float*)(ws + WS_LSE); bf16* MIX = (bf16*)(ws + WS_MIX);
        LAS float* Km = (LAS float*)(ldsl); LAS float* Vm = Km + 16 * 516;
        for (int c = tid; c < 2 * 16 * 64; c += NWAVES * 64) { const int which = c >> 10, j = (c >> 6) & 15, ch = c & 63;
            const v4u w = *(const v4u*)((which ? VB : KB) + (size_t)(KPAD - NMETA + j) * 512 + ch * 8); float f[8]; unpack8(w, f);
            LAS float* d = (which ? Vm : Km) + j * 516 + ch * 8; *(LAS f32x4*)d = (f32x4){f[0], f[1], f[2], f[3]}; *(LAS f32x4*)(d + 4) = (f32x4){f[4], f[5], f[6], f[7]}; }
        __syncthreads();
        float lam;
        { const float a = wave_sum(args.in[I_LQ1][lane] * args.in[I_LK1][lane]), b = wave_sum(args.in[I_LQ2][lane] * args.in[I_LK2][lane]); lam = expf(a) - expf(b) + LAM_INIT; }
        const int h = lane >> 4, i = lane & 15;
        float sg[8];
#pragma unroll
        for (int e = 0; e < 8; ++e) sg[e] = args.in[I_SUBG][8 * i + e] * (1.0f - LAM_INIT);
        const __amdgpu_buffer_rsrc_t mixr = __builtin_amdgcn_make_buffer_rsrc(MIX, 0, (int)((unsigned)MA * D * 2u), 0x00020000);
        auto finish_row = [&](int R, float (&o8)[8]) {
            float ss = 0.f;
#pragma unroll
            for (int e = 0; e < 8; ++e) ss += o8[e] * o8[e];
            ss += __shfl_xor(ss, 1); ss += __shfl_xor(ss, 2); ss += __shfl_xor(ss, 4); ss += __shfl_xor(ss, 8);
            const float rs = 1.0f / sqrtf(ss * (1.0f / 128.0f) + EPS);
#pragma unroll
            for (int e = 0; e < 8; ++e) o8[e] *= rs * sg[e];
            v4u o; o.x = pk2(o8[0], o8[1]); o.y = pk2(o8[2], o8[3]); o.z = pk2(o8[4], o8[5]); o.w = pk2(o8[6], o8[7]); __builtin_amdgcn_raw_buffer_store_b128(o, mixr, (unsigned)((R * D + 512 + h * 128 + 8 * i) * 2), 0, 16);
        };
        const int ch = h * 128 + 8 * i, w = 2 << h;
        {
            const int R0 = 8 * gw, b = R0 >> 13, pos0 = (R0 & (T - 1)) + NMETA; float sum[8] = {0.f, 0.f, 0.f, 0.f, 0.f, 0.f, 0.f, 0.f};
            auto urow = [&](int pp) { return UB + (size_t)(pp >= NMETA ? b * T + pp - NMETA : MR + pp) * 512 + ch; };
#pragma unroll 4
            for (int kk = 1; kk < 16; ++kk) { if (kk < w) { const v4u wv = *(const v4u*)urow(pos0 - kk); float f[8]; unpack8(wv, f);
#pragma unroll
                    for (int e = 0; e < 8; ++e) sum[e] += f[e]; } }
            const float invw = 1.0f / (float)w;
#pragma unroll 1
            for (int r0 = 0; r0 < 8; r0 += 4) {
                v4u wcv[4], wov[4], o0v[4], o1v[4];
#pragma unroll
                for (int k = 0; k < 4; ++k) { const int R = R0 + r0 + k, pos = pos0 + r0 + k;
                    wcv[k] = *(const v4u*)urow(pos); wov[k] = *(const v4u*)urow(pos - w);
                    o0v[k] = *(const v4u*)(OB + (size_t)R * 1024 + h * 256 + 8 * i); o1v[k] = *(const v4u*)(OB + (size_t)R * 1024 + h * 256 + 128 + 8 * i); }
                asm volatile("" ::: "memory");
#pragma unroll
                for (int k = 0; k < 4; ++k) { const int R = R0 + r0 + k;
                    float cur[8], old[8]; unpack8(wcv[k], cur); unpack8(wov[k], old); float pl[8];
#pragma unroll
                    for (int e = 0; e < 8; ++e) { if (r0 + k > 0) sum[e] -= old[e]; sum[e] += cur[e]; pl[e] = sum[e] * invw - cur[e]; }
                    v4u o; o.x = pk2(pl[0], pl[1]); o.y = pk2(pl[2], pl[3]); o.z = pk2(pl[4], pl[5]); o.w = pk2(pl[6], pl[7]); __builtin_amdgcn_raw_buffer_store_b128(o, mixr, (unsigned)((R * D + ch) * 2), 0, 16);
                    float a0[8], a1[8], o8[8]; unpack8(o0v[k], a0); unpack8(o1v[k], a1);
#pragma unroll
                    for (int e = 0; e < 8; ++e) o8[e] = a0[e] - lam * a1[e];
                    finish_row(R, o8); }
                asm volatile("" ::: "memory"); }
        }
        if (gw < NMETA) {
            const int pos = gw, R = MR + pos, cnt = (pos + 1) < w ? (pos + 1) : w; float sum[8] = {0.f, 0.f, 0.f, 0.f, 0.f, 0.f, 0.f, 0.f}, cur[8] = {0.f, 0.f, 0.f, 0.f, 0.f, 0.f, 0.f, 0.f};
            for (int kk = 0; kk < 16; ++kk) { if (kk < cnt) { const v4u wv = *(const v4u*)(UB + (size_t)(MR + pos - kk) * 512 + ch); float f[8]; unpack8(wv, f);
#pragma unroll
                    for (int e = 0; e < 8; ++e) { sum[e] += f[e]; if (kk == 0) cur[e] = f[e]; } } }
            const float inv = 1.0f / (float)cnt; float pl[8];
#pragma unroll
            for (int e = 0; e < 8; ++e) pl[e] = sum[e] * inv - cur[e];
            v4u o; o.x = pk2(pl[0], pl[1]); o.y = pk2(pl[2], pl[3]); o.z = pk2(pl[4], pl[5]); o.w = pk2(pl[6], pl[7]); *(v4u*)(MIX + (size_t)R * D + ch) = o;
            float o8[8] = {0.f, 0.f, 0.f, 0.f, 0.f, 0.f, 0.f, 0.f};
            const bool b3 = (i & 8) != 0, b2 = (i & 4) != 0, b1 = (i & 2) != 0, b0 = (i & 1) != 0;
#pragma unroll 1
            for (int c = 0; c < 2; ++c) {
                const unsigned long long qw = *(const unsigned long long*)(QB_ + (size_t)R * 512 + h * 128 + c * 64 + 4 * i);
                const float q0 = bflo((unsigned)qw), q1 = bfhi((unsigned)qw), q2 = bflo((unsigned)(qw >> 32)), q3 = bfhi((unsigned)(qw >> 32));
                const LAS float* kp = Km + h * 128 + c * 64 + 4 * i; float part[16];
#pragma unroll
                for (int j = 0; j < 16; ++j) { const f32x4 k = *(const LAS f32x4*)(kp + j * 516); part[j] = (q0 * k[0] + q1 * k[1]) + (q2 * k[2] + q3 * k[3]); }
#pragma unroll
                for (int j = 0; j < 8; ++j) { const float keep = b3 ? part[j + 8] : part[j], send = b3 ? part[j] : part[j + 8]; part[j] = keep + __shfl_xor(send, 8); }
#pragma unroll
                for (int j = 0; j < 4; ++j) { const float keep = b2 ? part[j + 4] : part[j], send = b2 ? part[j] : part[j + 4]; part[j] = keep + __shfl_xor(send, 4); }
#pragma unroll
                for (int j = 0; j < 2; ++j) { const float keep = b1 ? part[j + 2] : part[j], send = b1 ? part[j] : part[j + 2]; part[j] = keep + __shfl_xor(send, 2); }
                float sc; { const float keep = b0 ? part[1] : part[0], send = b0 ? part[0] : part[1]; sc = keep + __shfl_xor(send, 1); }
                if (i > pos) sc = -INFINITY;
                float m = sc; m = fmaxf(m, __shfl_xor(m, 1)); m = fmaxf(m, __shfl_xor(m, 2)); m = fmaxf(m, __shfl_xor(m, 4)); m = fmaxf(m, __shfl_xor(m, 8));
                const float p = exp2f(sc - m); float l = p; l += __shfl_xor(l, 1); l += __shfl_xor(l, 2); l += __shfl_xor(l, 4); l += __shfl_xor(l, 8);
                float om[8] = {0.f, 0.f, 0.f, 0.f, 0.f, 0.f, 0.f, 0.f};
#pragma unroll 4
                for (int j = 0; j < 16; ++j) { const float pj = __shfl(p, (lane & 48) + j); const LAS float* vp = Vm + j * 516 + h * 128 + 8 * i; const f32x4 v0 = *(const LAS f32x4*)vp, v1 = *(const LAS f32x4*)(vp + 4);
                    om[0] += pj * v0[0]; om[1] += pj * v0[1]; om[2] += pj * v0[2]; om[3] += pj * v0[3]; om[4] += pj * v1[0]; om[5] += pj * v1[1]; om[6] += pj * v1[2]; om[7] += pj * v1[3]; }
                const float coef = ((c == 0) ? 1.0f : -lam) / l;
#pragma unroll
                for (int e = 0; e < 8; ++e) o8[e] += om[e] * coef;
            }
            finish_row(R, o8);
        }
    }
    GRID_SYNC();

#pragma unroll 1
    for (int rep_ = 0; rep_ < REP_P3; ++rep_) {
        PHASE_IDS();
        bf16* Wo_t = (bf16*)(ws + WS_WO); float* BEFF = (float*)(ws + WS_BEFF); float* H1M = (float*)(ws + WS_H1M); float* SSQ = (float*)(ws + WS_SSQ); bf16* XN = (bf16*)(ws + WS_XN); bf16* MIX = (bf16*)(ws + WS_MIX); const float* x = args.in[I_X]; const float* meta = args.in[I_META]; float* out = args.out;
        meta_tiles<true>(bx, D / 16, MIX + (size_t)MR * D, D, nullptr, Wo_t, D, (LAS float*)(ldsl + RING_OFF), lane, wave, [&](const f32x4& acc, float ss, int n0) { (void)ss;
            const int col = n0 + (lane & 15);
#pragma unroll
            for (int j = 0; j < 4; ++j) { const int row = 4 * (lane >> 4) + j; H1M[row * D + col] = meta[row * D + col] + acc[j] + BEFF[col]; } });
        pg8::Gemm g{MIX, Wo_t, MR, D, D}; pg8::StaticOrder S; S.init(MR, D, G, bx);
        pg8::EpiWo E{x, XN, BEFF, SSQ};
        pg8::gemm_phase<pg8::EpiWo, pg8::StaticOrder, false, PG8_SP2>(ldsl + RING_OFF, g, S, E);
    }
    GRID_SYNC();

#pragma unroll 1
    for (int rep_ = 0; rep_ < REP_P4; ++rep_) {
        PHASE_IDS();
        bf16* Wup_t = (bf16*)(ws + WS_WUP); float* H1M = (float*)(ws + WS_H1M); float* UM = (float*)(ws + WS_UM); float* SSQ = (float*)(ws + WS_SSQ); float* HRAW = (float*)(ws + WS_HRAW); bf16* XN = (bf16*)(ws + WS_XN); bf16* ACT = (bf16*)(ws + WS_ACT);
        meta_tiles<false>(255 - bx, NUP / 16, H1M, D, nullptr, Wup_t, D, (LAS float*)(ldsl + RING_OFF), lane, wave, [&](const f32x4& acc, float ss, int n0) {
            const float rstd = 1.0f / sqrtf(ss * (1.0f / D) + EPS); const int col = n0 + (lane & 15);
#pragma unroll
            for (int j = 0; j < 4; ++j) { const int row = 4 * (lane >> 4) + j; const float rsr = __shfl(rstd, row); UM[row * NUP + col] = acc[j] * rsr; } });
        pg8::Gemm g{XN, Wup_t, MR, NUP, D}; pg8::StaticOrder S; S.init(MR, NUP, G, bx);
        pg8::EpiUp E{SSQ, args.in[I_CONVW], args.in[I_CONVB], ACT, HRAW};
        pg8::gemm_phase<pg8::EpiUp, pg8::StaticOrder, PG8_ALIGN, PG8_SP2>(ldsl + RING_OFF, g, S, E);
        if (bx >= 128) {
            bf16* Wdn_t = (bf16*)(ws + WS_WDN); LAS float* scr = (LAS float*)(ldsl + RING_OFF + wave * 16384);
            for (int r = (bx - 128) * NWAVES + wave; r < (DFF / 64) * (D / 32); r += 128 * NWAVES) { const int nblk = D / 32, kb = r / nblk, nb = r % nblk;
                transpose_item(args.in[I_WDOWN], D, 64 * kb, 32 * nb, Wdn_t, DFF, 32 * nb, 64 * kb, scr, lane); }
        }
    }
    GRID_SYNC();

#pragma unroll 1
    for (int rep_ = 0; rep_ < REP_P4H; ++rep_) {
        PHASE_IDS();
        float* UM = (float*)(ws + WS_UM); float* HRAW = (float*)(ws + WS_HRAW); bf16* ACT = (bf16*)(ws + WS_ACT);
        const float* cw = args.in[I_CONVW]; const float* cb = args.in[I_CONVB];
        for (int idx = bx * (NWAVES * 64) + tid; idx < 256 * DFF; idx += G * NWAVES * 64) {
            const int blk = idx / DFF, j = idx - blk * DFF, ng = (j >> 7) * 256 + (j & 127);
            const float* h0 = HRAW + (size_t)blk * 4 * NUP; const float* pm2 = (blk & 127) ? HRAW + (size_t)(blk - 1) * 4 * NUP : UM + 14 * NUP; const float* pm1 = pm2 + NUP;
            float c0[2], c1[2];
#pragma unroll
            for (int gv = 0; gv < 2; ++gv) { const int np = ng + gv * 128, cc = j + gv * DFF; const float u_2 = pm2[np], u_1 = pm1[np], u0 = h0[2 * NUP + np], u1 = h0[3 * NUP + np];
                const float w0 = cw[cc], w1 = cw[NUP + cc], w2 = cw[2 * NUP + cc], bb = cb[cc];
                c0[gv] = w0 * u_2 + w1 * u_1 + w2 * u0 + bb; c1[gv] = w0 * u_1 + w1 * u0 + w2 * u1 + bb; }
            ACT[(size_t)(64 * blk) * DFF + j] = (bf16)f2bf(pg8::silu_mul(c0[0], c0[1])); ACT[(size_t)(64 * blk + 1) * DFF + j] = (bf16)f2bf(pg8::silu_mul(c1[0], c1[1]));
        }
    }
    GRID_SYNC();

#pragma unroll 1
    for (int rep_ = 0; rep_ < REP_P5; ++rep_) {
        PHASE_IDS();
        bf16* Wdn_t = (bf16*)(ws + WS_WDN); bf16* ACT = (bf16*)(ws + WS_ACT); float* out = args.out;
        pg8::Gemm g{ACT, Wdn_t, MR, D, DFF}; pg8::StaticOrder S; S.init(MR, D, G, bx);
        pg8::EpiDown E{(const bf16*)(ws + WS_XN), out};
        pg8::gemm_phase<pg8::EpiDown, pg8::StaticOrder, PG8_ALIGN, PG8_SP2>(ldsl + RING_OFF, g, S, E);
    }
}

extern "C" void kernel_launch(void* const* d_in, const int* in_sizes, int n_in, void* d_out, int out_size, void* d_ws, size_t ws_size, hipStream_t stream) {
    static int grid = 0;
    if (grid == 0) {
        if (n_in != 20 || in_sizes[0] != MR * D || out_size != MR * D || ws_size < WS_END) { fprintf(stderr, "kernel_launch: unexpected shapes (n_in %d, in0 %d, out %d, ws %zu)\n", n_in, n_in > 0 ? in_sizes[0] : -1, out_size, ws_size); grid = -1; return; }
        if (hipFuncSetAttribute((const void*)hymba_fwd, hipFuncAttributeMaxDynamicSharedMemorySize, LDS_BYTES) != hipSuccess) { fprintf(stderr, "kernel_launch: hipFuncSetAttribute failed\n"); grid = -1; return; }
        int dev = 0, cus = 0, per_cu = 0;
        (void)hipGetDevice(&dev); (void)hipDeviceGetAttribute(&cus, hipDeviceAttributeMultiprocessorCount, dev);
        (void)hipOccupancyMaxActiveBlocksPerMultiprocessor(&per_cu, (const void*)hymba_fwd, NWAVES * 64, LDS_BYTES);
        (void)hipGetLastError();
        if (cus < 256 || per_cu < 1) fprintf(stderr, "kernel_launch: note: %d CUs, %d blocks per CU reported; this kernel needs 256 co-resident workgroups\n", cus, per_cu);
        grid = 256;
    }
    if (grid < 0) return;
    if (hipMemsetAsync((char*)d_ws + WS_BAR, 0, XCD_BAR_WORDS * 4, stream) != hipSuccess) { fprintf(stderr, "kernel_launch: hipMemsetAsync failed\n"); return; }
    Args a{};
    for (int i = 0; i < 20; ++i) a.in[i] = (const float*)d_in[i];
    a.out = (float*)d_out; a.ws = (unsigned char*)d_ws;
    void* kargs[] = {&a};
    const hipError_t le = hipLaunchCooperativeKernel((const void*)hymba_fwd, dim3(grid), dim3(NWAVES * 64), kargs, LDS_BYTES, stream);
    if (le != hipSuccess) fprintf(stderr, "kernel_launch: cooperative launch failed: %s\n", hipGetErrorName(le));
}
```
